# Optimizing an MI355X kernel written in HIP

```python
import math
import jax, jax.numpy as jnp
from jax import lax
import numpy as np

D_MODEL = 1024
BATCH = 32
SEQ = 256
DEPTH = 2
DEC_BATCH = 2
DEC_SEQ = 2048
PAST_LEN = 512

GRID_W = 64
CHUNK = 128
SHORT_CONV_W = 5
FFN_CONV_W = 3
N_MOD = 6
EPS = 1e-6

SSD_HEADS = 16
SSD_HEAD_DIM = 64
SSD_INNER = SSD_HEADS * SSD_HEAD_DIM
SSD_GROUPS = 4
SSD_STATE = 128
DN_HEADS = 8
DN_KEY_DIM = 128
DN_VAL_DIM = 128
DN_QK = DN_HEADS * DN_KEY_DIM
DN_V = DN_HEADS * DN_VAL_DIM
SG_GROUPS = 4
SG_WIDTH = 1024
SG_GROUP_DIM = SG_WIDTH // SG_GROUPS
ATTN_HEADS = 8
ATTN_KV_HEADS = 2
ATTN_GROUP = ATTN_HEADS // ATTN_KV_HEADS
ATTN_HEAD_DIM = 128
WINDOW = 128
ROPE_THETA = 10000.0
ROPE_PAIRS_AXIS = ATTN_HEAD_DIM // 4
D_FF = 2816

L0_SIZES = (SSD_INNER, SSD_INNER + 2 * SSD_GROUPS * SSD_STATE, 2 * SSD_HEADS,
            2 * DN_QK + DN_V, DN_V, 2 * DN_HEADS, 2 * DN_HEADS)
L0_PROJ = sum(L0_SIZES)
L0_MIX = SSD_INNER + DN_V
L1_SIZES = (2 * SG_WIDTH, ATTN_HEADS * ATTN_HEAD_DIM, ATTN_KV_HEADS * ATTN_HEAD_DIM, ATTN_KV_HEADS * ATTN_HEAD_DIM)
L1_PROJ = sum(L1_SIZES)
L1_MIX = SG_WIDTH + ATTN_HEADS * ATTN_HEAD_DIM

F32 = jnp.float32

kernel_name = 'hybrid_diffusion_prefix_step'


def _offsets(sizes):
    out, acc = [], 0
    for s in sizes[:-1]:
        acc += s
        out.append(acc)
    return out


def flip(t):
    return t[:, ::-1]


def rmsnorm(x, w):
    xf = x.astype(F32)
    y = xf * lax.rsqrt(jnp.mean(xf * xf, axis=-1, keepdims=True) + EPS)
    return (y * w.astype(F32)).astype(x.dtype)


def layernorm(x, w, b):
    xf = x.astype(F32)
    xc = xf - jnp.mean(xf, axis=-1, keepdims=True)
    y = xc * lax.rsqrt(jnp.mean(xc * xc, axis=-1, keepdims=True) + EPS)
    return (y * w.astype(F32) + b.astype(F32)).astype(x.dtype)


def l2norm(x):
    xf = x.astype(F32)
    return xf * lax.rsqrt(jnp.sum(xf * xf, axis=-1, keepdims=True) + EPS)


def dwconv(x, w, b=None):
    width = w.shape[0]
    pad = width // 2
    length = x.shape[1]
    xp = jnp.pad(x, ((0, 0), (pad, pad), (0, 0)))
    y = xp[:, 0:length] * w[0]
    for tap in range(1, width):
        y = y + xp[:, tap:tap + length] * w[tap]
    return y if b is None else y + b


def modulated_rmsnorm(x, w, shift, scale):
    return rmsnorm(x, w) * (1.0 + scale[:, None, :]) + shift[:, None, :]


def adaln(cond, w, b):
    return (jax.nn.silu(cond.astype(F32)) @ w + b).reshape(cond.shape[0], N_MOD, D_MODEL)


def ssd_scan(x, dt, A, Bm, Cm, h0):
    bsz, length, nh, hp = x.shape
    ns = Bm.shape[-1]
    nc = length // CHUNK
    xc = x.astype(F32).reshape(bsz, nc, CHUNK, nh, hp)
    bc = Bm.astype(F32).reshape(bsz, nc, CHUNK, nh, ns)
    cc = Cm.astype(F32).reshape(bsz, nc, CHUNK, nh, ns)
    dtc = dt.astype(F32).reshape(bsz, nc, CHUNK, nh)
    acs = jnp.cumsum(dtc * A.astype(F32), axis=2)
    tril = jnp.tril(jnp.ones((CHUNK, CHUNK), bool))[:, :, None]
    seg = acs[:, :, :, None, :] - acs[:, :, None, :, :]
    lmat = jnp.exp(jnp.where(tril, seg, -jnp.inf))
    xdt = xc * dtc[..., None]
    scores = jnp.einsum('bcihn,bcjhn->bcijh', cc, bc) * lmat
    y_diag = jnp.einsum('bcijh,bcjhp->bcihp', scores, xdt)
    decay_to_end = jnp.exp(acs[:, :, -1:, :] - acs)
    chunk_states = jnp.einsum('bcjhn,bcjh,bcjhp->bchpn', bc, decay_to_end, xdt)
    chunk_decay = jnp.exp(acs[:, :, -1, :])

    def step(h, inp):
        st, dec = inp
        return h * dec[:, :, None, None] + st, h

    h_fin, h_prev = lax.scan(step, h0.astype(F32),
                             (jnp.moveaxis(chunk_states, 1, 0), jnp.moveaxis(chunk_decay, 1, 0)))
    h_prev = jnp.moveaxis(h_prev, 0, 1)
    y_off = jnp.einsum('bcihn,bchpn,bcih->bcihp', cc, h_prev, jnp.exp(acs))
    return (y_diag + y_off).reshape(bsz, length, nh, hp), h_fin


def gated_delta_scan(q, k, v, g, beta, s0):
    bsz, length, nh, dk = q.shape
    dv = v.shape[-1]
    nc = length // CHUNK

    def to_chunks(t):
        t = t.astype(F32).reshape((bsz, nc, CHUNK) + t.shape[2:])
        return jnp.moveaxis(t, 3, 2)

    qc = to_chunks(q) * (dk ** -0.5)
    kc = to_chunks(k)
    vc = to_chunks(v)
    bc = to_chunks(beta)
    gcs = jnp.cumsum(to_chunks(g), axis=-1)
    tril = jnp.tril(jnp.ones((CHUNK, CHUNK), bool))
    strict = jnp.tril(jnp.ones((CHUNK, CHUNK), bool), -1)
    decay = jnp.exp(jnp.where(tril, gcs[..., :, None] - gcs[..., None, :], -jnp.inf))
    kbeta = kc * bc[..., None]
    a_strict = jnp.where(strict, jnp.einsum('bchid,bchjd->bchij', kbeta, kc) * decay, 0.0)
    ia = a_strict + jnp.eye(CHUNK, dtype=F32)
    u = lax.linalg.triangular_solve(ia, vc * bc[..., None], left_side=True, lower=True)
    w = lax.linalg.triangular_solve(ia, kbeta * jnp.exp(gcs)[..., None], left_side=True, lower=True)
    qk = jnp.einsum('bchid,bchjd->bchij', qc, kc) * decay
    q_dec = qc * jnp.exp(gcs)[..., None]
    k_end = kc * jnp.exp(gcs[..., -1:] - gcs)[..., None]
    last = jnp.exp(gcs[..., -1])

    def step(s, inp):
        qk_c, qd_c, w_c, u_c, ke_c, last_c = inp
        v_new = u_c - jnp.einsum('bhik,bhkv->bhiv', w_c, s)
        o_c = jnp.einsum('bhik,bhkv->bhiv', qd_c, s) + jnp.einsum('bhij,bhjv->bhiv', qk_c, v_new)
        s = s * last_c[..., None, None] + jnp.einsum('bhjk,bhjv->bhkv', ke_c, v_new)
        return s, o_c

    xs = (jnp.moveaxis(qk, 1, 0), jnp.moveaxis(q_dec, 1, 0), jnp.moveaxis(w, 1, 0),
          jnp.moveaxis(u, 1, 0), jnp.moveaxis(k_end, 1, 0), jnp.moveaxis(last, 1, 0))
    s_fin, o = lax.scan(step, s0.astype(F32), xs)
    o = jnp.moveaxis(jnp.moveaxis(o, 0, 1), 2, 3).reshape(bsz, length, nh, dv)
    return o, s_fin


def ssd_delta_mixer(h, ssd_h0, dn_h0, w_in, w_out, ssd_conv_w, ssd_conv_b, ssd_dt_bias, ssd_A_log,
                    ssd_D, ssd_norm_w, dn_conv_w, dn_dt_bias, dn_A_log, dn_norm_w):
    bsz, length, _ = h.shape
    z, xbc, dt_raw, qkv, gate, a_raw, b_raw = jnp.split(h @ w_in, _offsets(L0_SIZES), axis=-1)
    xbc = jax.nn.silu(dwconv(xbc, ssd_conv_w, ssd_conv_b))
    xs, bm, cm = jnp.split(xbc, [SSD_INNER, SSD_INNER + SSD_GROUPS * SSD_STATE], axis=-1)
    xs = xs.reshape(bsz, length, SSD_HEADS, SSD_HEAD_DIM)
    rep = SSD_HEADS // SSD_GROUPS
    bh = jnp.repeat(bm.reshape(bsz, length, SSD_GROUPS, SSD_STATE), rep, axis=2)
    ch = jnp.repeat(cm.reshape(bsz, length, SSD_GROUPS, SSD_STATE), rep, axis=2)
    dt = jax.nn.softplus(dt_raw.astype(F32).reshape(bsz, length, 2, SSD_HEADS) + ssd_dt_bias.astype(F32))
    a_ssd = -jnp.exp(ssd_A_log.astype(F32))
    y_f, h_f = ssd_scan(xs, dt[:, :, 0], a_ssd[0], bh, ch, ssd_h0[:, 0])
    y_b, h_b = ssd_scan(flip(xs), flip(dt[:, :, 1]), a_ssd[1], flip(bh), flip(ch), ssd_h0[:, 1])
    y = y_f + flip(y_b) + ssd_D.astype(F32)[:, None] * xs.astype(F32)
    y = rmsnorm(y.reshape(bsz, length, SSD_INNER) * jax.nn.silu(z.astype(F32)), ssd_norm_w)
    qkv = jax.nn.silu(dwconv(qkv, dn_conv_w))
    q, k, v = jnp.split(qkv, [DN_QK, 2 * DN_QK], axis=-1)
    q = l2norm(q.reshape(bsz, length, DN_HEADS, DN_KEY_DIM))
    k = l2norm(k.reshape(bsz, length, DN_HEADS, DN_KEY_DIM))
    v = v.reshape(bsz, length, DN_HEADS, DN_VAL_DIM)
    g = -jnp.exp(dn_A_log.astype(F32)) * jax.nn.softplus(
        a_raw.astype(F32).reshape(bsz, length, 2, DN_HEADS) + dn_dt_bias.astype(F32))
    beta = jax.nn.sigmoid(b_raw.astype(F32).reshape(bsz, length, 2, DN_HEADS))
    o_f, s_f = gated_delta_scan(q, k, v, g[:, :, 0], beta[:, :, 0], dn_h0[:, 0])
    o_b, s_b = gated_delta_scan(flip(q), flip(k), flip(v), flip(g[:, :, 1]), flip(beta[:, :, 1]), dn_h0[:, 1])
    o = rmsnorm(o_f + flip(o_b), dn_norm_w) * jax.nn.silu(gate.astype(F32)).reshape(bsz, length, DN_HEADS, DN_VAL_DIM)
    mixed = jnp.concatenate([y, o.reshape(bsz, length, DN_V)], axis=-1).astype(h.dtype)
    return mixed @ w_out, jnp.stack([h_f, h_b], axis=1), jnp.stack([s_f, s_b], axis=1)


def axial_rope_tables(length):
    rows = length // GRID_W
    row = jnp.repeat(jnp.arange(rows, dtype=F32), GRID_W)
    col = jnp.tile(jnp.arange(GRID_W, dtype=F32), rows)
    inv = ROPE_THETA ** (-jnp.arange(ROPE_PAIRS_AXIS, dtype=F32) / ROPE_PAIRS_AXIS)
    ang = jnp.concatenate([row[:, None] * inv, col[:, None] * inv], axis=-1)
    return jnp.cos(ang), jnp.sin(ang)


def apply_rope(x, cos, sin):
    half = x.shape[-1] // 2
    x1 = x[..., :half].astype(F32)
    x2 = x[..., half:].astype(F32)
    c = cos[None, :, None, :]
    s = sin[None, :, None, :]
    return jnp.concatenate([x1 * c - x2 * s, x2 * c + x1 * s], axis=-1).astype(x.dtype)


def sink_attend(q, k, v, mask, sink):
    s = jnp.einsum('bqkgd,bskd->bkgqs', q.astype(F32), k.astype(F32)) * (ATTN_HEAD_DIM ** -0.5)
    if mask is not None:
        s = jnp.where(mask, s, -jnp.inf)
    sink_col = jnp.broadcast_to(sink.astype(F32).reshape(ATTN_KV_HEADS, ATTN_GROUP)[None, :, :, None, None],
                                s.shape[:-1] + (1,))
    p = jax.nn.softmax(jnp.concatenate([s, sink_col], axis=-1), axis=-1)[..., :-1]
    o = jnp.einsum('bkgqs,bskd->bqkgd', p, v.astype(F32))
    return o.reshape(o.shape[0], o.shape[1], ATTN_HEADS * ATTN_HEAD_DIM)


def context_attention(q, k, v, sink):
    bsz, length = q.shape[:2]
    nb = length // CHUNK
    qb = jnp.swapaxes(q.reshape(bsz, nb, CHUNK, ATTN_KV_HEADS, ATTN_GROUP, ATTN_HEAD_DIM), 0, 1)
    ob = lax.map(lambda qq: sink_attend(qq, k, v, None, sink), qb)
    return jnp.swapaxes(ob, 0, 1).reshape(bsz, length, ATTN_HEADS * ATTN_HEAD_DIM)


def latent_attention(q, k, v, k_ctx, v_ctx, sink):
    bsz, length = q.shape[:2]
    nb = length // CHUNK
    band = 3 * CHUNK
    pad = ((0, 0), (CHUNK, CHUNK), (0, 0), (0, 0))
    kp = jnp.pad(k, pad)
    vp = jnp.pad(v, pad)
    k_ctx = k_ctx.astype(k.dtype)
    v_ctx = v_ctx.astype(v.dtype)
    n_ctx = k_ctx.shape[1]
    qb = jnp.swapaxes(q.reshape(bsz, nb, CHUNK, ATTN_KV_HEADS, ATTN_GROUP, ATTN_HEAD_DIM), 0, 1)

    def block(args):
        i, qq = args
        start = i * CHUNK
        kb = jnp.concatenate([lax.dynamic_slice_in_dim(kp, start, band, axis=1), k_ctx], axis=1)
        vb = jnp.concatenate([lax.dynamic_slice_in_dim(vp, start, band, axis=1), v_ctx], axis=1)
        qpos = start + jnp.arange(CHUNK)
        kpos = start - CHUNK + jnp.arange(band)
        near = ((jnp.abs(qpos[:, None] - kpos[None, :]) <= WINDOW)
                & (kpos >= 0)[None, :] & (kpos < length)[None, :])
        mask = jnp.concatenate([near, jnp.ones((CHUNK, n_ctx), bool)], axis=1)
        return sink_attend(qq, kb, vb, mask, sink)

    ob = lax.map(block, (jnp.arange(nb), qb))
    return jnp.swapaxes(ob, 0, 1).reshape(bsz, length, ATTN_HEADS * ATTN_HEAD_DIM)


def _l1_branches(h, w_in, sg_ln_w, sg_ln_b, sg_w_s, sg_b_s):
    bsz, length, _ = h.shape
    uv, q, k, v = jnp.split(h @ w_in, _offsets(L1_SIZES), axis=-1)
    u, gv = jnp.split(jax.nn.gelu(uv), 2, axis=-1)
    gv = layernorm(gv, sg_ln_w, sg_ln_b).reshape(bsz, length // CHUNK, CHUNK, SG_GROUPS, SG_GROUP_DIM)
    sv = jnp.einsum('gij,bcjgd->bcigd', sg_w_s, gv) + sg_b_s.T[:, :, None]
    mlp_out = u * sv.reshape(bsz, length, SG_WIDTH)
    q = q.reshape(bsz, length, ATTN_HEADS, ATTN_HEAD_DIM)
    k = k.reshape(bsz, length, ATTN_KV_HEADS, ATTN_HEAD_DIM)
    v = v.reshape(bsz, length, ATTN_KV_HEADS, ATTN_HEAD_DIM)
    return mlp_out, q, k, v


def l1_mixer_context(h, w_in, w_out, sg_ln_w, sg_ln_b, sg_w_s, sg_b_s, attn_sink):
    mlp_out, q, k, v = _l1_branches(h, w_in, sg_ln_w, sg_ln_b, sg_w_s, sg_b_s)
    attn_out = context_attention(q, k, v, attn_sink)
    out = jnp.concatenate([mlp_out, attn_out.astype(mlp_out.dtype)], axis=-1) @ w_out
    return out, k, v


def l1_mixer_latent(h, k_ctx, v_ctx, w_in, w_out, sg_ln_w, sg_ln_b, sg_w_s, sg_b_s, attn_sink):
    mlp_out, q, k, v = _l1_branches(h, w_in, sg_ln_w, sg_ln_b, sg_w_s, sg_b_s)
    cos, sin = axial_rope_tables(h.shape[1])
    attn_out = latent_attention(apply_rope(q, cos, sin), apply_rope(k, cos, sin), v, k_ctx, v_ctx, attn_sink)
    return jnp.concatenate([mlp_out, attn_out.astype(mlp_out.dtype)], axis=-1) @ w_out


def conv_ffn(h, w_up, conv_w, conv_b, w_down):
    a, b = jnp.split(dwconv(h @ w_up, conv_w, conv_b), 2, axis=-1)
    return (jax.nn.silu(a) * b) @ w_down


def setup_inputs(seed: int = 0) -> dict:
    key = jax.random.key(seed)
    keys = iter(jax.random.split(key, 64))

    def nrm(shape, scale=1.0):
        return scale * jax.random.normal(next(keys), shape, F32)

    def gain(n):
        return 1.0 + 0.1 * jax.random.normal(next(keys), (n,), F32)

    def dt_bias(shape):
        dt = jnp.exp(jax.random.uniform(next(keys), shape, F32, math.log(1e-3), math.log(1e-1)))
        return dt + jnp.log(-jnp.expm1(-dt))

    def a_log(shape):
        return jnp.log(jax.random.uniform(next(keys), shape, F32, 1.0, 16.0))

    inp = {}
    inp['x_prompt'] = nrm((BATCH, SEQ, D_MODEL))
    inp['x_sample'] = nrm((DEC_BATCH, DEC_SEQ, D_MODEL))
    inp['state_l0_ssd'] = nrm((DEC_BATCH, 2, SSD_HEADS, SSD_HEAD_DIM, SSD_STATE), 0.5)
    inp['state_l0_dn'] = nrm((DEC_BATCH, 2, DN_HEADS, DN_KEY_DIM, DN_VAL_DIM), 0.5)
    inp['cache_l1_k'] = nrm((DEC_BATCH, PAST_LEN, ATTN_KV_HEADS, ATTN_HEAD_DIM))
    inp['cache_l1_v'] = nrm((DEC_BATCH, PAST_LEN, ATTN_KV_HEADS, ATTN_HEAD_DIM))
    inp['c'] = nrm((DEC_BATCH, D_MODEL))
    inp['c_ctx'] = nrm((D_MODEL,))
    for l in range(DEPTH):
        inp['mod_w_l%d' % l] = nrm((D_MODEL, N_MOD * D_MODEL), 0.5 * D_MODEL ** -0.5)
        inp['mod_b_l%d' % l] = nrm((N_MOD * D_MODEL,), 0.02)
        inp['norm_mix_pre_l%d' % l] = gain(D_MODEL)
        inp['norm_mix_post_l%d' % l] = gain(D_MODEL)
        inp['norm_ffn_pre_l%d' % l] = gain(D_MODEL)
        inp['norm_ffn_post_l%d' % l] = gain(D_MODEL)
        inp['ffn_up_l%d' % l] = nrm((D_MODEL, 2 * D_FF), D_MODEL ** -0.5)
        inp['ffn_conv_w_l%d' % l] = nrm((FFN_CONV_W, 2 * D_FF), FFN_CONV_W ** -0.5)
        inp['ffn_conv_b_l%d' % l] = nrm((2 * D_FF,), 0.02)
        inp['ffn_down_l%d' % l] = nrm((D_FF, D_MODEL), D_FF ** -0.5)
    inp['mix_in_l0'] = nrm((D_MODEL, L0_PROJ), D_MODEL ** -0.5)
    inp['mix_out_l0'] = nrm((L0_MIX, D_MODEL), L0_MIX ** -0.5)
    inp['ssd_conv_w'] = nrm((SHORT_CONV_W, SSD_INNER + 2 * SSD_GROUPS * SSD_STATE), SHORT_CONV_W ** -0.5)
    inp['ssd_conv_b'] = nrm((SSD_INNER + 2 * SSD_GROUPS * SSD_STATE,), 0.02)
    inp['ssd_dt_bias'] = dt_bias((2, SSD_HEADS))
    inp['ssd_A_log'] = a_log((2, SSD_HEADS))
    inp['ssd_D'] = gain(SSD_HEADS)
    inp['ssd_norm_w'] = gain(SSD_INNER)
    inp['dn_conv_w'] = nrm((SHORT_CONV_W, 2 * DN_QK + DN_V), SHORT_CONV_W ** -0.5)
    inp['dn_dt_bias'] = dt_bias((2, DN_HEADS))
    inp['dn_A_log'] = a_log((2, DN_HEADS))
    inp['dn_norm_w'] = gain(DN_VAL_DIM)
    inp['mix_in_l1'] = nrm((D_MODEL, L1_PROJ), D_MODEL ** -0.5)
    inp['mix_out_l1'] = nrm((L1_MIX, D_MODEL), L1_MIX ** -0.5)
    inp['sg_ln_w'] = gain(SG_WIDTH)
    inp['sg_ln_b'] = nrm((SG_WIDTH,), 0.02)
    inp['sg_w_s'] = nrm((SG_GROUPS, CHUNK, CHUNK), CHUNK ** -0.5)
    inp['sg_b_s'] = 1.0 + nrm((SG_GROUPS, CHUNK), 0.1)
    inp['attn_sink'] = nrm((ATTN_HEADS,))
    return inp


def reference(x_prompt, x_sample, state_l0_ssd, state_l0_dn, cache_l1_k, cache_l1_v, c, c_ctx,
              mod_w_l0, mod_b_l0, norm_mix_pre_l0, norm_mix_post_l0, norm_ffn_pre_l0, norm_ffn_post_l0,
              ffn_up_l0, ffn_conv_w_l0, ffn_conv_b_l0, ffn_down_l0,
              mod_w_l1, mod_b_l1, norm_mix_pre_l1, norm_mix_post_l1, norm_ffn_pre_l1, norm_ffn_post_l1,
              ffn_up_l1, ffn_conv_w_l1, ffn_conv_b_l1, ffn_down_l1,
              mix_in_l0, mix_out_l0, ssd_conv_w, ssd_conv_b, ssd_dt_bias, ssd_A_log, ssd_D, ssd_norm_w,
              dn_conv_w, dn_dt_bias, dn_A_log, dn_norm_w,
              mix_in_l1, mix_out_l1, sg_ln_w, sg_ln_b, sg_w_s, sg_b_s, attn_sink):
    mod_w = (mod_w_l0, mod_w_l1)
    mod_b = (mod_b_l0, mod_b_l1)
    n_mix_pre = (norm_mix_pre_l0, norm_mix_pre_l1)
    n_mix_post = (norm_mix_post_l0, norm_mix_post_l1)
    n_ffn_pre = (norm_ffn_pre_l0, norm_ffn_pre_l1)
    n_ffn_post = (norm_ffn_post_l0, norm_ffn_post_l1)
    ffn = ((ffn_up_l0, ffn_conv_w_l0, ffn_conv_b_l0, ffn_down_l0),
           (ffn_up_l1, ffn_conv_w_l1, ffn_conv_b_l1, ffn_down_l1))
    l0_mix = (mix_in_l0, mix_out_l0, ssd_conv_w, ssd_conv_b, ssd_dt_bias, ssd_A_log, ssd_D, ssd_norm_w,
              dn_conv_w, dn_dt_bias, dn_A_log, dn_norm_w)
    l1_mix = (mix_in_l1, mix_out_l1, sg_ln_w, sg_ln_b, sg_w_s, sg_b_s, attn_sink)

    xp, xs = x_prompt, x_sample
    for layer in range(DEPTH):
        mod_p = adaln(c_ctx[None, :], mod_w[layer], mod_b[layer])
        mod_s = adaln(c, mod_w[layer], mod_b[layer])
        hp = modulated_rmsnorm(xp, n_mix_pre[layer], mod_p[:, 0], mod_p[:, 1])
        hs = modulated_rmsnorm(xs, n_mix_pre[layer], mod_s[:, 0], mod_s[:, 1])
        if layer % 2 == 0:
            zero_ssd = jnp.zeros((xp.shape[0],) + state_l0_ssd.shape[1:], F32)
            zero_dn = jnp.zeros((xp.shape[0],) + state_l0_dn.shape[1:], F32)
            op, new_ssd, new_dn = ssd_delta_mixer(hp, zero_ssd, zero_dn, *l0_mix)
            os_, _, _ = ssd_delta_mixer(hs, state_l0_ssd, state_l0_dn, *l0_mix)
        else:
            op, new_k, new_v = l1_mixer_context(hp, *l1_mix)
            os_ = l1_mixer_latent(hs, cache_l1_k, cache_l1_v, *l1_mix)
        xp = xp + mod_p[:, 2, None, :] * rmsnorm(op, n_mix_post[layer])
        xs = xs + mod_s[:, 2, None, :] * rmsnorm(os_, n_mix_post[layer])
        hp = modulated_rmsnorm(xp, n_ffn_pre[layer], mod_p[:, 3], mod_p[:, 4])
        hs = modulated_rmsnorm(xs, n_ffn_pre[layer], mod_s[:, 3], mod_s[:, 4])
        xp = xp + mod_p[:, 5, None, :] * rmsnorm(conv_ffn(hp, *ffn[layer]), n_ffn_post[layer])
        xs = xs + mod_s[:, 5, None, :] * rmsnorm(conv_ffn(hs, *ffn[layer]), n_ffn_post[layer])
    return (xp, xs, new_ssd, new_dn, new_k, new_v)
```

```cpp
#include <hip/hip_runtime.h>
#include <hip/hip_cooperative_groups.h>
#include <cstdio>
namespace cg = cooperative_groups;

typedef unsigned short bf16_t;
using bf16x8 = __attribute__((ext_vector_type(8))) short;
using f32x4 = __attribute__((ext_vector_type(4))) float;
using u32x4 = __attribute__((ext_vector_type(4))) unsigned;
using u32x2 = __attribute__((ext_vector_type(2))) unsigned;

#ifndef SINGLE_LAUNCH
#define SINGLE_LAUNCH 1
#endif

constexpr int NT = 256;
constexpr int TTOK = 12288;
constexpr int TP = 8192;
constexpr int LDS_BYTES = 73728;
constexpr int NPHASE = 19;
#ifndef PROBE_LONG2
#define PROBE_LONG2 0
#endif
#ifndef PROBE_ATT2
#define PROBE_ATT2 0
#endif
#ifndef PROBE_GATE2
#define PROBE_GATE2 0
#endif
#ifndef PH_ONLY
#define PH_ONLY -1
#endif
#ifndef PH_SKIP
#define PH_SKIP -1
#endif
#ifndef PH_SKIP2
#define PH_SKIP2 -1
#endif
#define PH_ON(x) ((PH_ONLY < 0 || PH_ONLY == (x)) && (x) != PH_SKIP && (x) != PH_SKIP2)

constexpr size_t OFF_MOD = 0;
constexpr size_t OFF_COS = 147456;
constexpr size_t OFF_SIN = OFF_COS + 524288;
constexpr size_t OFF_KC = OFF_SIN + 524288;
constexpr size_t OFF_VCT = OFF_KC + 524288;
constexpr size_t OFF_WSB = OFF_VCT + 524288;
constexpr size_t OFF_SMALL = OFF_WSB + 131072;
constexpr size_t OFF_A = 6291456;
constexpr size_t OFF_WIN0 = OFF_A;
constexpr size_t OFF_WOUT0 = OFF_WIN0 + 14942208;
constexpr size_t OFF_PF = OFF_WOUT0 + 4194304;
constexpr size_t OFF_ACT = OFF_A;
constexpr size_t OFF_B = 79691776;
constexpr size_t OFF_WUP0 = OFF_B;
constexpr size_t OFF_WDN0 = OFF_WUP0 + 11534336;
constexpr size_t OFF_WIN1 = OFF_WDN0 + 5767168;
constexpr size_t OFF_WOUT1 = OFF_WIN1 + 7340032;
constexpr size_t OFF_WUP1 = OFF_WOUT1 + 4194304;
constexpr size_t OFF_WDN1 = OFF_WUP1 + 11534336;
constexpr size_t OFF_C = OFF_WDN1 + 5767168;
constexpr size_t OFF_VT = OFF_C + 88080384;
constexpr size_t WS_NEED = OFF_C + 138412032;
static_assert(OFF_SMALL + 3145728 <= OFF_A, "small");
static_assert(OFF_PF + 50331648 <= OFF_B, "A region");
static_assert(OFF_ACT + 69206016 <= OFF_B, "act");
static_assert(OFF_B + 177733632 <= 268435456, "proj0");
static_assert(OFF_VT + 6291456 <= WS_NEED, "vt");
static_assert(WS_NEED <= 268435456, "ws");

constexpr size_t OUT_SSD = 12582912;
constexpr size_t OUT_DN = 20971520;
constexpr size_t OUT_K = 29360128;
constexpr size_t OUT_V = 31457280;

struct Params {
  const float* in[47];
  float* out;
  unsigned char* ws;
  int ph_lo, ph_hi;
};

typedef __bf16 bf16v2 __attribute__((ext_vector_type(2)));
typedef float f32v2 __attribute__((ext_vector_type(2)));
__device__ __forceinline__ unsigned short f2bf(float f) { const __bf16 b = (__bf16)f; return __builtin_bit_cast(unsigned short, b); }
__device__ __forceinline__ float bf2f(unsigned short h) { return __uint_as_float(((unsigned)h) << 16); }
__device__ __forceinline__ unsigned pack2(float a, float b) {
  const bf16v2 r = __builtin_convertvector((f32v2){a, b}, bf16v2);
  return __builtin_bit_cast(unsigned, r);
}
__device__ __forceinline__ float bflo(unsigned u) { return __uint_as_float(u << 16); }
__device__ __forceinline__ float bfhi(unsigned u) { return __uint_as_float(u & 0xffff0000u); }
template <int CTRL>
__device__ __forceinline__ float dppf(float v) { return __int_as_float(__builtin_amdgcn_update_dpp(0, __float_as_int(v), CTRL, 0xF, 0xF, true)); }
__device__ __forceinline__ float row16_sum(float v) { v += dppf<0xB1>(v); v += dppf<0x4E>(v); v += dppf<0x141>(v); v += dppf<0x140>(v); return v; }
__device__ __forceinline__ float row16_max(float v) { v = fmaxf(v, dppf<0xB1>(v)); v = fmaxf(v, dppf<0x4E>(v)); v = fmaxf(v, dppf<0x141>(v)); v = fmaxf(v, dppf<0x140>(v)); return v; }
__device__ __forceinline__ float wsum(float v) {
  v = row16_sum(v);
  v += __shfl_xor(v, 16);
  v += __shfl_xor(v, 32);
  return v;
}
__device__ __forceinline__ float siluf(float x) { return x * __builtin_amdgcn_rcpf(1.f + __expf(-x)); }
__device__ __forceinline__ float softplusf(float x) { return x > 20.f ? x : log1pf(expf(x)); }
__device__ __forceinline__ float geluf(float x) {
  const float u2 = 1.5957691216057308f * (x + 0.044715f * x * x * x);
  return x * __builtin_amdgcn_rcpf(1.f + __expf(-u2));
}

#define XB_TMO      128
#define XB_XCNT(j)  (256  + 64 * (j))
#define XB_XSUB(j)  (1280 + 64 * (j))
#define XB_XGEN(j)  (2304 + 64 * (j))
#define XB_TOP      3328
#define XB_TOPGEN   3392
#define XCD_BAR_WORDS 3456
#define XB_SPIN_CAP (1u << 18)
#define LAS __attribute__((address_space(3)))
__device__ __forceinline__ unsigned xb_ld(unsigned* p)              { return __hip_atomic_load(p, __ATOMIC_RELAXED, __HIP_MEMORY_SCOPE_AGENT); }
__device__ __forceinline__ unsigned xb_add(unsigned* p, unsigned v) { return __hip_atomic_fetch_add(p, v, __ATOMIC_RELAXED, __HIP_MEMORY_SCOPE_AGENT); }
__device__ __forceinline__ unsigned xb_xcc_id() { return (unsigned)__builtin_amdgcn_s_getreg((3 << 11) | 20) & 0xFu; }
#define XB_SPIN(cond, bar) do { unsigned _sp = 0; while (cond) { __builtin_amdgcn_s_sleep(1); \
    if ((++_sp & 255u) == 0u) { if (xb_ld(&(bar)[XB_TMO])) break; if (_sp > XB_SPIN_CAP) { atomicAdd(&(bar)[XB_TMO], 1u); break; } } } } while (0)
struct XcdBarrier { unsigned* bar; unsigned x; volatile LAS unsigned* st; };
__device__ __forceinline__ XcdBarrier xcd_barrier_post(unsigned* bar, volatile LAS unsigned* st) {
    XcdBarrier b; b.bar = bar; b.x = xb_xcc_id(); b.st = st;
    if (threadIdx.x == 0) (void)xb_add(&bar[XB_XCNT(b.x)], 1u);
    return b;
}
__device__ __forceinline__ void xcd_barrier_complete(unsigned* bar, unsigned x, unsigned& nloc, unsigned& nx) {
    const unsigned G = gridDim.x * gridDim.y * gridDim.z;
    unsigned sum, cnt, mine, sp = 0u;
    for (;;) {
        sum = 0u; cnt = 0u; mine = 0u;
#pragma unroll
        for (unsigned j = 0; j < 16; ++j) { const unsigned c = xb_ld(&bar[XB_XCNT(j)]); sum += c; cnt += (c > 0u) ? 1u : 0u; mine = (j == x) ? c : mine; }
        if (sum == G) break;
        __builtin_amdgcn_s_sleep(1);
        if ((++sp & 255u) == 0u) { if (xb_ld(&bar[XB_TMO])) break; if (sp > XB_SPIN_CAP) { atomicAdd(&bar[XB_TMO], 1u); break; } }
    }
    nloc = mine > 0u ? mine : 1u; nx = cnt > 0u ? cnt : 1u;
}
__device__ __forceinline__ void xcd_barrier(const XcdBarrier& b) {
    asm volatile("s_waitcnt vmcnt(0)" ::: "memory");
    __syncthreads();
    if (threadIdx.x == 0) {
        unsigned* bar = b.bar;
        __builtin_amdgcn_s_waitcnt(0);
        unsigned nloc = b.st[0], nx = b.st[1];
        if (nloc == 0u) { xcd_barrier_complete(bar, b.x, nloc, nx); b.st[0] = nloc; b.st[1] = nx; }
        const unsigned old = xb_add(&bar[XB_XSUB(b.x)], 1u);
        const unsigned gen = old / nloc;
        if (old + 1u == (gen + 1u) * nloc) {
            __builtin_amdgcn_fence(__ATOMIC_RELEASE, "agent");
            asm volatile("s_waitcnt vmcnt(0)" ::: "memory");
            const unsigned og = xb_add(&bar[XB_TOP], 1u);
            const unsigned tg = og / nx;
            if (og + 1u == (tg + 1u) * nx) xb_add(&bar[XB_TOPGEN], 1u);
            else XB_SPIN(xb_ld(&bar[XB_TOPGEN]) == tg, bar);
            __builtin_amdgcn_fence(__ATOMIC_ACQUIRE, "agent");
            xb_add(&bar[XB_XGEN(b.x)], 1u);
            asm volatile("s_waitcnt vmcnt(0)" ::: "memory");
        } else {
            XB_SPIN(xb_ld(&bar[XB_XGEN(b.x)]) == gen, bar);
            __builtin_amdgcn_fence(__ATOMIC_ACQUIRE, "agent");
            asm volatile("s_waitcnt vmcnt(0)" ::: "memory");
        }
    }
    __syncthreads();
}

__device__ __forceinline__ void sub_barrier(unsigned* cnt, unsigned target, unsigned* tmo) {
  asm volatile("s_waitcnt vmcnt(0)" ::: "memory");
  __syncthreads();
  if (threadIdx.x == 0) {
    __builtin_amdgcn_fence(__ATOMIC_RELEASE, "agent");
    asm volatile("s_waitcnt vmcnt(0)" ::: "memory");
    xb_add(cnt, 1u);
    unsigned sp = 0;
    while (xb_ld(cnt) < target) {
      __builtin_amdgcn_s_sleep(1);
      if ((++sp & 255u) == 0u) { if (xb_ld(tmo)) break; if (sp > XB_SPIN_CAP) { atomicAdd(tmo, 1u); break; } }
    }
    __builtin_amdgcn_fence(__ATOMIC_ACQUIRE, "agent");
    asm volatile("s_waitcnt vmcnt(0)" ::: "memory");
  }
  __syncthreads();
}

template <int MT, class Epi>
__device__ __forceinline__ void gemm_tile_big(const bf16_t* __restrict__ Ag, int lda, const bf16_t* __restrict__ Bg, int ldb,
                                              int K, int row_base, int col_base, unsigned char* smem, Epi& epi) {
  bf16_t* As = (bf16_t*)smem;
  bf16_t* Bs = As + (32 * MT) * 72;
  const int tid = threadIdx.x, lane = tid & 63, w = tid >> 6, wr = w >> 1, wc = w & 1, fr = lane & 15, fq = lane >> 4;
  f32x4 acc[MT][4];
#pragma unroll
  for (int m = 0; m < MT; ++m)
#pragma unroll
    for (int n = 0; n < 4; ++n) acc[m][n] = (f32x4){0.f, 0.f, 0.f, 0.f};
  u32x4 pa[MT], pb[4];
  const int lrow = tid >> 3, lkc = (tid & 7) * 8;
  const bf16_t* Ap = Ag + (size_t)lrow * lda + lkc;
  const bf16_t* Bp = Bg + (size_t)lrow * ldb + lkc;
#define G_LOAD(k0_) { _Pragma("unroll") for (int i = 0; i < MT; ++i) pa[i] = *(const u32x4*)(Ap + (size_t)(i * 32) * lda + (k0_)); \
                      _Pragma("unroll") for (int i = 0; i < 4; ++i) pb[i] = *(const u32x4*)(Bp + (size_t)(i * 32) * ldb + (k0_)); }
  G_LOAD(0);
  const int nk = K >> 6;
  for (int kt = 0; kt < nk; ++kt) {
    __syncthreads();
#pragma unroll
    for (int i = 0; i < MT; ++i) *(u32x4*)(As + (lrow + i * 32) * 72 + lkc) = pa[i];
#pragma unroll
    for (int i = 0; i < 4; ++i) *(u32x4*)(Bs + (lrow + i * 32) * 72 + lkc) = pb[i];
    __syncthreads();
    if (kt + 1 < nk) G_LOAD((kt + 1) << 6);
#pragma unroll
    for (int kk = 0; kk < 2; ++kk) {
      bf16x8 b[4];
#pragma unroll
      for (int n = 0; n < 4; ++n) b[n] = *(const bf16x8*)(Bs + (wc * 64 + n * 16 + fr) * 72 + kk * 32 + fq * 8);
#pragma unroll
      for (int m = 0; m < MT; ++m) {
        const bf16x8 a = *(const bf16x8*)(As + (wr * (16 * MT) + m * 16 + fr) * 72 + kk * 32 + fq * 8);
#pragma unroll
        for (int n = 0; n < 4; ++n) acc[m][n] = __builtin_amdgcn_mfma_f32_16x16x32_bf16(b[n], a, acc[m][n], 0, 0, 0);
      }
    }
  }
#undef G_LOAD
  __syncthreads();
  {
    bf16_t* Cw = (bf16_t*)smem + w * 9216;
    const bool dog = epi.gelu(col_base);
#pragma unroll
    for (int m = 0; m < MT; ++m)
#pragma unroll
      for (int n = 0; n < 4; ++n) {
        float v0 = acc[m][n][0], v1 = acc[m][n][1], v2 = acc[m][n][2], v3 = acc[m][n][3];
        epi.side(row_base + wr * (16 * MT) + m * 16 + fr, col_base + wc * 64 + n * 16 + fq * 4, v0, v1, v2, v3);
        if (dog) { v0 = geluf(v0); v1 = geluf(v1); v2 = geluf(v2); v3 = geluf(v3); }
        u32x2 o; o.x = pack2(v0, v1); o.y = pack2(v2, v3);
        *(u32x2*)(Cw + (m * 16 + fr) * 72 + n * 16 + fq * 4) = o;
      }
    asm volatile("s_waitcnt lgkmcnt(0)" ::: "memory");
#pragma unroll
    for (int i = 0; i < 2 * MT; ++i) {
      const int r = i * 8 + (lane >> 3), c8 = (lane & 7) * 8;
      const u32x4 v = *(const u32x4*)(Cw + r * 72 + c8);
      epi.store16(row_base + wr * (16 * MT) + r, col_base + wc * 64 + c8, v);
    }
  }
}

template <int MT, class Epi>
__device__ __forceinline__ void gemm_phase(const bf16_t* A, int lda, const bf16_t* Bt, int ldb, int nM, int nN, int K,
                                           unsigned char* smem, Epi epi, int tm_off = 0, int b_off = 0) {
  if ((int)blockIdx.x < b_off) return;
  if ((blockIdx.x >> 8) & 1) __builtin_amdgcn_s_sleep(15);
  const int nb = gridDim.x - b_off, b = blockIdx.x - b_off;
  int x, sl, nsl, nx;
  if ((nb & 7) == 0) { nx = 8; x = b & 7; sl = b >> 3; nsl = nb >> 3; } else { nx = 1; x = 0; sl = b; nsl = nb; }
#ifndef PMS
#define PMS 3
#endif
  constexpr int PM = 1 << PMS, PN = 64 >> PMS;
  const int nPn = (nN + PN - 1) / PN, nPm = (nM + PM - 1) / PM, npatch = nPn * nPm;
  for (int q = sl;; q += nsl) {
    const int pid = (q >> 6) * nx + x;
    if (pid >= npatch) break;
    const int slot = q & 63;
    const int tm = (pid / nPn) * PM + (slot & (PM - 1)), tn = (pid % nPn) * PN + (slot >> PMS);
    if (tm >= nM || tn >= nN) continue;
    gemm_tile_big<MT>(A + (size_t)((tm_off + tm) * 32 * MT) * lda, lda, Bt + (size_t)(tn * 128) * ldb, ldb, K, (tm_off + tm) * 32 * MT, tn * 128, smem, epi);
  }
}

struct EpiIn0 {
  bf16_t* proj; float* small;
  __device__ __forceinline__ bool gelu(int) const { return false; }
  __device__ __forceinline__ void side(int row, int col, float v0, float v1, float v2, float v3) const {
    if (col >= 3072 && col < 3104) *(float4*)(small + row * 64 + (col - 3072)) = make_float4(v0, v1, v2, v3);
    else if (col >= 7200 && col < 7232) *(float4*)(small + row * 64 + 32 + (col - 7200)) = make_float4(v0, v1, v2, v3);
  }
  __device__ __forceinline__ void store16(int row, int col, u32x4 v) const {
    if (col < 7232) *(u32x4*)(proj + (size_t)row * 7232 + col) = v;
  }
};
struct EpiOp {
  bf16_t* o;
  __device__ __forceinline__ bool gelu(int) const { return false; }
  __device__ __forceinline__ void side(int, int, float, float, float, float) const {}
  __device__ __forceinline__ void store16(int row, int col, u32x4 v) const { *(u32x4*)(o + (size_t)row * 1024 + col) = v; }
};
struct EpiUp {
  bf16_t* o;
  __device__ __forceinline__ bool gelu(int) const { return false; }
  __device__ __forceinline__ void side(int, int, float, float, float, float) const {}
  __device__ __forceinline__ void store16(int row, int col, u32x4 v) const { *(u32x4*)(o + (size_t)row * 5632 + col) = v; }
};
struct EpiIn1 {
  bf16_t* proj; bf16_t* vT; float* outk; float* outv;
  __device__ __forceinline__ bool gelu(int col_base) const { return col_base < 2048; }
  __device__ __forceinline__ void side(int row, int col, float v0, float v1, float v2, float v3) const {
    if (col >= 3072) {
      if (col < 3328) {
        if (row < TP) *(float4*)(outk + (size_t)row * 256 + (col - 3072)) = make_float4(v0, v1, v2, v3);
      } else {
        const int cv = col - 3328;
        vT[(size_t)(cv + 0) * TTOK + row] = f2bf(v0); vT[(size_t)(cv + 1) * TTOK + row] = f2bf(v1);
        vT[(size_t)(cv + 2) * TTOK + row] = f2bf(v2); vT[(size_t)(cv + 3) * TTOK + row] = f2bf(v3);
        if (row < TP) *(float4*)(outv + (size_t)row * 256 + cv) = make_float4(v0, v1, v2, v3);
      }
    }
  }
  __device__ __forceinline__ void store16(int row, int col, u32x4 v) const {
    if (col < 3328) *(u32x4*)(proj + (size_t)row * 3584 + col) = v;
  }
};

__device__ __forceinline__ void tconv_item(const float* __restrict__ src, int K, int N, bf16_t* __restrict__ dst, int item, unsigned char* smem) {
  float* t = (float*)smem;
  const int nkt = K >> 6;
  const int kt = item % nkt, nt = item / nkt;
  const int k0 = kt * 64, n0 = nt * 64;
  const int tid = threadIdx.x;
  __syncthreads();
  {
    const int c4 = (tid & 15) * 4;
#pragma unroll
    for (int i = 0; i < 4; ++i) {
      const int kk = (tid >> 4) + 16 * i;
      float4 v = make_float4(0.f, 0.f, 0.f, 0.f);
      if (n0 + c4 < N) v = *(const float4*)(src + (size_t)(k0 + kk) * N + n0 + c4);
      t[kk * 65 + c4 + 0] = v.x; t[kk * 65 + c4 + 1] = v.y; t[kk * 65 + c4 + 2] = v.z; t[kk * 65 + c4 + 3] = v.w;
    }
  }
  __syncthreads();
  {
    const int kc = (tid & 7) * 8;
#pragma unroll
    for (int i = 0; i < 2; ++i) {
      const int n = (tid >> 3) + 32 * i;
      u32x4 o;
      o.x = pack2(t[(kc + 0) * 65 + n], t[(kc + 1) * 65 + n]);
      o.y = pack2(t[(kc + 2) * 65 + n], t[(kc + 3) * 65 + n]);
      o.z = pack2(t[(kc + 4) * 65 + n], t[(kc + 5) * 65 + n]);
      o.w = pack2(t[(kc + 6) * 65 + n], t[(kc + 7) * 65 + n]);
      *(u32x4*)(dst + (size_t)(n0 + n) * K + k0 + kc) = o;
    }
  }
}

__device__ __forceinline__ void adaln_item(const Params& p, int item, unsigned char* smem) {
  float* sc = (float*)smem;
  float* red = sc + 3072;
  const int tid = threadIdx.x;
  const int layer = item / 192, cc = item % 192;
  const float* mw = p.in[layer == 0 ? 8 : 18];
  const float* mb = p.in[layer == 0 ? 9 : 19];
  __syncthreads();
  for (int i = tid; i < 3072; i += NT) {
    const int r = i >> 10, k = i & 1023;
    const float c = (r == 0) ? p.in[7][k] : p.in[6][(r - 1) * 1024 + k];
    sc[i] = siluf(c);
  }
  __syncthreads();
  const int cl = tid & 31, kg = tid >> 5;
  const float* wp = mw + cc * 32 + cl;
  float a0 = 0.f, a1 = 0.f, a2 = 0.f;
  for (int k0 = kg; k0 < 1024; k0 += 256) {
    float wv[32];
#pragma unroll
    for (int u = 0; u < 32; ++u) wv[u] = wp[(size_t)(k0 + 8 * u) * 6144];
#pragma unroll
    for (int u = 0; u < 32; ++u) {
      const int k = k0 + 8 * u;
      a0 += sc[k] * wv[u]; a1 += sc[1024 + k] * wv[u]; a2 += sc[2048 + k] * wv[u];
    }
  }
  red[(kg * 3 + 0) * 32 + cl] = a0; red[(kg * 3 + 1) * 32 + cl] = a1; red[(kg * 3 + 2) * 32 + cl] = a2;
  __syncthreads();
  if (tid < 96) {
    const int r = tid >> 5;
    float sacc = 0.f;
#pragma unroll
    for (int g = 0; g < 8; ++g) sacc += red[(g * 3 + r) * 32 + cl];
    float* mods = (float*)(p.ws + OFF_MOD);
    const int col = cc * 32 + cl;
    mods[(layer * 3 + r) * 6144 + col] = sacc + mb[col];
  }
}

__device__ __forceinline__ void prep_phase(const Params& p, unsigned char* smem) {
  const int tid = threadIdx.x;
  constexpr int I_ADA = 384, I_WIN0 = 16 * 114, I_WOUT0 = 32 * 16, I_WS = 64, I_ROPE = 128, I_KV = 256;
  constexpr int TOT = I_ADA + I_WIN0 + I_WOUT0 + I_WS + I_ROPE + I_KV;
  for (int it = blockIdx.x; it < TOT; it += gridDim.x) {
    int i = it;
    if (i < I_ADA) { adaln_item(p, i, smem); continue; }
    i -= I_ADA;
    if (i < I_WIN0 + I_WOUT0) {
      const bool first = i < I_WIN0;
      tconv_item(first ? p.in[28] : p.in[29], first ? 1024 : 2048, first ? 7232 : 1024,
                 (bf16_t*)(p.ws + (first ? OFF_WIN0 : OFF_WOUT0)), first ? i : i - I_WIN0, smem);
      continue;
    }
    i -= I_WIN0 + I_WOUT0;
    if (i < I_WS) {
      const int e = i * 1024 + tid * 4;
      const float4 v = *(const float4*)(p.in[44] + e);
      u32x2 o; o.x = pack2(v.x, v.y); o.y = pack2(v.z, v.w);
      *(u32x2*)((bf16_t*)(p.ws + OFF_WSB) + e) = o;
      continue;
    }
    i -= I_WS;
    if (i < I_ROPE) {
      float* ct = (float*)(p.ws + OFF_COS); float* st = (float*)(p.ws + OFF_SIN);
#pragma unroll
      for (int u = 0; u < 4; ++u) {
        const int e = i * 1024 + u * 256 + tid;
        const int t = e >> 6, j = e & 63;
        const float pos = (j < 32) ? (float)(t >> 6) : (float)(t & 63);
        const float inv = powf(10000.0f, -(float)(j & 31) / 32.0f);
        const float ang = pos * inv;
        ct[e] = cosf(ang); st[e] = sinf(ang);
      }
      continue;
    }
    i -= I_ROPE;
    {
      const int e = i * 1024 + tid * 4;
      const int d = e & 127, kh = (e >> 7) & 1, pos = (e >> 8) & 511, b = e >> 17;
      const float4 kv = *(const float4*)(p.in[4] + e);
      u32x2 o; o.x = pack2(kv.x, kv.y); o.y = pack2(kv.z, kv.w);
      *(u32x2*)((bf16_t*)(p.ws + OFF_KC) + ((size_t)((b * 2 + kh) * 512 + pos)) * 128 + d) = o;
      const float4 vv = *(const float4*)(p.in[5] + e);
      bf16_t* vd = (bf16_t*)(p.ws + OFF_VCT) + ((size_t)((b * 2 + kh) * 128 + d)) * 512 + pos;
      vd[0] = f2bf(vv.x); vd[512] = f2bf(vv.y); vd[1024] = f2bf(vv.z); vd[1536] = f2bf(vv.w);
    }
  }
}

__device__ __forceinline__ void modnorm_store(const float (&v)[16], float ss, const float* __restrict__ w, const float* __restrict__ shift,
                                              const float* __restrict__ scale, bf16_t* __restrict__ hrow, int lane) {
  const float rstd = rsqrtf(ss * (1.f / 1024.f) + 1e-6f);
#pragma unroll
  for (int i = 0; i < 4; ++i) {
    const int c = lane * 4 + 256 * i;
    const float4 ww = *(const float4*)(w + c), sh = *(const float4*)(shift + c), sc = *(const float4*)(scale + c);
    const float h0 = v[i * 4 + 0] * rstd * ww.x * (1.f + sc.x) + sh.x;
    const float h1 = v[i * 4 + 1] * rstd * ww.y * (1.f + sc.y) + sh.y;
    const float h2 = v[i * 4 + 2] * rstd * ww.z * (1.f + sc.z) + sh.z;
    const float h3 = v[i * 4 + 3] * rstd * ww.w * (1.f + sc.w) + sh.w;
    u32x2 o; o.x = pack2(h0, h1); o.y = pack2(h2, h3);
    *(u32x2*)(hrow + c) = o;
  }
}

__device__ __forceinline__ void norm0_phase(const Params& p) {
  const int lane = threadIdx.x & 63, w = threadIdx.x >> 6;
  const float* mods = (const float*)(p.ws + OFF_MOD);
  bf16_t* hbuf = (bf16_t*)(p.ws + OFF_PF);
  for (int row = blockIdx.x * 4 + w; row < TTOK; row += gridDim.x * 4) {
    const float* xr = row < TP ? p.in[0] + (size_t)row * 1024 : p.in[1] + (size_t)(row - TP) * 1024;
    const int mr = row < TP ? 0 : 1 + ((row - TP) >> 11);
    const float* mod = mods + (0 * 3 + mr) * 6144;
    float v[16]; float ss = 0.f;
#pragma unroll
    for (int i = 0; i < 4; ++i) {
      const float4 t = *(const float4*)(xr + lane * 4 + 256 * i);
      v[i * 4] = t.x; v[i * 4 + 1] = t.y; v[i * 4 + 2] = t.z; v[i * 4 + 3] = t.w;
      ss += t.x * t.x + t.y * t.y + t.z * t.z + t.w * t.w;
    }
    ss = wsum(ss);
    modnorm_store(v, ss, p.in[10], mod, mod + 1024, hbuf + (size_t)row * 1024, lane);
  }
}

__device__ __forceinline__ void post_phase(const Params& p, int layer, int which) {
  const int lane = threadIdx.x & 63, w = threadIdx.x >> 6;
  const float* mods = (const float*)(p.ws + OFF_MOD);
  const bf16_t* op = (const bf16_t*)(p.ws + OFF_C);
  bf16_t* hbuf = (bf16_t*)(p.ws + OFF_PF);
  const int lb = layer == 0 ? 8 : 18;
  const float* wpost = p.in[lb + (which == 0 ? 3 : 5)];
  const bool has_next = !(layer == 1 && which == 1);
  const float* wnext = which == 0 ? p.in[lb + 4] : p.in[20];
  const int nlayer = which == 0 ? layer : 1;
  const int sidx = which == 0 ? 3 : 0;
  for (int row = blockIdx.x * 4 + w; row < TTOK; row += gridDim.x * 4) {
    const int mr = row < TP ? 0 : 1 + ((row - TP) >> 11);
    const float* mod = mods + (layer * 3 + mr) * 6144;
    const float* gate = mod + (which == 0 ? 2 : 5) * 1024;
    const float* xold;
    if (layer == 0 && which == 0) xold = row < TP ? p.in[0] + (size_t)row * 1024 : p.in[1] + (size_t)(row - TP) * 1024;
    else xold = p.out + (size_t)row * 1024;
    const bf16_t* orow = op + (size_t)row * 1024;
    float v[16]; float ss = 0.f;
#pragma unroll
    for (int i = 0; i < 4; ++i) {
      const u32x2 tt = *(const u32x2*)(orow + lane * 4 + 256 * i);
      const float4 t = make_float4(bflo(tt.x), bfhi(tt.x), bflo(tt.y), bfhi(tt.y));
      v[i * 4] = t.x; v[i * 4 + 1] = t.y; v[i * 4 + 2] = t.z; v[i * 4 + 3] = t.w;
      ss += t.x * t.x + t.y * t.y + t.z * t.z + t.w * t.w;
    }
    ss = wsum(ss);
    const float rstd = rsqrtf(ss * (1.f / 1024.f) + 1e-6f);
    float ss2 = 0.f;
#pragma unroll
    for (int i = 0; i < 4; ++i) {
      const int c = lane * 4 + 256 * i;
      const float4 xo = *(const float4*)(xold + c), ww = *(const float4*)(wpost + c), gg = *(const float4*)(gate + c);
      float4 xn;
      xn.x = xo.x + gg.x * (v[i * 4 + 0] * rstd * ww.x);
      xn.y = xo.y + gg.y * (v[i * 4 + 1] * rstd * ww.y);
      xn.z = xo.z + gg.z * (v[i * 4 + 2] * rstd * ww.z);
      xn.w = xo.w + gg.w * (v[i * 4 + 3] * rstd * ww.w);
      *(float4*)(p.out + (size_t)row * 1024 + c) = xn;
      v[i * 4] = xn.x; v[i * 4 + 1] = xn.y; v[i * 4 + 2] = xn.z; v[i * 4 + 3] = xn.w;
      ss2 += xn.x * xn.x + xn.y * xn.y + xn.z * xn.z + xn.w * xn.w;
    }
    if (has_next) {
      ss2 = wsum(ss2);
      const float* nmod = mods + (nlayer * 3 + mr) * 6144;
      modnorm_store(v, ss2, wnext, nmod + sidx * 1024, nmod + (sidx + 1) * 1024, hbuf + (size_t)row * 1024, lane);
    }
  }
}

__device__ __forceinline__ float wave_incl_scan(float v, int lane) {
  v += dppf<0x111>(v); v += dppf<0x112>(v); v += dppf<0x114>(v); v += dppf<0x118>(v);
  const float r0 = __int_as_float(__builtin_amdgcn_readlane(__float_as_int(v), 15));
  if (lane >= 16) v += r0;
  return v;
}

template <int NOUT, int NCH, class F>
__device__ __forceinline__ void conv_chan(const bf16_t* rc, float w0, float w1, float w2, float w3, float w4, float bias, F f) {
  float r0 = bf2f(rc[0]), r1 = bf2f(rc[NCH]), r2 = bf2f(rc[2 * NCH]), r3 = bf2f(rc[3 * NCH]);
#pragma unroll
  for (int i = 0; i < NOUT; ++i) {
    const float r4 = bf2f(rc[(i + 4) * NCH]);
    const float v = bias + r0 * w0 + r1 * w1 + r2 * w2 + r3 * w3 + r4 * w4;
    f(i, siluf(v));
    r0 = r1; r1 = r2; r2 = r3; r3 = r4;
  }
}

__device__ __forceinline__ void ssd_item(const Params& p, int seq, int dir, int h, unsigned char* smem) {
  const int tid = threadIdx.x, lane = tid & 63, w = tid >> 6, fr = lane & 15, fq = lane >> 4;
  const int rt = w & 1, ch = w >> 1;
  bf16_t* Ct = (bf16_t*)smem;
  bf16_t* Bt = (bf16_t*)(smem + 8704);
  bf16_t* BdT = (bf16_t*)(smem + 17408);
  bf16_t* XT = (bf16_t*)(smem + 27648);
  bf16_t* SCR = (bf16_t*)(smem + 32768);
  bf16_t* PT = (bf16_t*)(smem + 35328);
  float* sc = (float*)(smem + 52736);
  bf16_t* RAW = (bf16_t*)smem;
  const int L = seq < 32 ? 256 : 2048;
  const int row0 = seq < 32 ? seq * 256 : TP + (seq - 32) * 2048;
  const bf16_t* proj = (const bf16_t*)(p.ws + OFF_B);
  const float* small = (const float*)(p.ws + OFF_SMALL);
  bf16_t* Pout = dir == 0 ? (bf16_t*)(p.ws + OFF_PF) : (bf16_t*)p.out;
  const int g = h >> 2;
  const float Aneg = -expf(p.in[33][dir * 16 + h]);
  const float dtb = p.in[32][dir * 16 + h];
  const float Dh = p.in[34][h];
  const int step = dir == 0 ? 1 : -1;
  const int qd = tid >> 6;
  int wcA, wcB;
  if (tid < 64) wcA = h * 64 + tid;
  else if (tid < 192) wcA = 1024 + g * 128 + (tid - 64);
  else wcA = 1536 + g * 128 + (tid - 192);
  wcB = 1536 + g * 128 + 64 + (tid & 63);
  float wa0, wa1, wa2, wa3, wa4, ba, wb0, wb1, wb2, wb3, wb4, bb;
  {
    const float* cw = p.in[30];
    const float t0 = cw[0 * 2048 + wcA], t1 = cw[1 * 2048 + wcA], t2 = cw[2 * 2048 + wcA], t3 = cw[3 * 2048 + wcA], t4 = cw[4 * 2048 + wcA];
    wa0 = dir ? t4 : t0; wa1 = dir ? t3 : t1; wa2 = t2; wa3 = dir ? t1 : t3; wa4 = dir ? t0 : t4;
    ba = p.in[31][wcA];
    const float u0 = cw[0 * 2048 + wcB], u1 = cw[1 * 2048 + wcB], u2 = cw[2 * 2048 + wcB], u3 = cw[3 * 2048 + wcB], u4 = cw[4 * 2048 + wcB];
    wb0 = dir ? u4 : u0; wb1 = dir ? u3 : u1; wb2 = u2; wb3 = dir ? u1 : u3; wb4 = dir ? u0 : u4;
    bb = p.in[31][wcB];
  }
  f32x4 accS[8];
  if (seq < 32) {
#pragma unroll
    for (int nt = 0; nt < 8; ++nt) accS[nt] = (f32x4){0.f, 0.f, 0.f, 0.f};
  } else {
    const float* s0 = p.in[2] + ((size_t)(((seq - 32) * 2 + dir) * 16 + h)) * 8192;
#pragma unroll
    for (int nt = 0; nt < 8; ++nt)
#pragma unroll
      for (int jj = 0; jj < 4; ++jj) accS[nt][jj] = s0[(16 * w + fq * 4 + jj) * 128 + nt * 16 + fr];
  }
#define SSD_PREFETCH(ci_) { const int tp_ = dir == 0 ? (ci_) * 32 : L - 1 - (ci_) * 32; \
    _Pragma("unroll") for (int u = 0; u < 6; ++u) pre[u] = (u32x4){0u, 0u, 0u, 0u}; \
    { const int t_ = tp_ + step * ((tid >> 3) - 2); \
      if (t_ >= 0 && t_ < L) { const bf16_t* rb_ = proj + (size_t)(row0 + t_) * 7232 + (tid & 7) * 8; \
        pre[0] = *(const u32x4*)(rb_ + 1024 + h * 64); pre[1] = *(const u32x4*)(rb_ + 2048 + g * 128); pre[2] = *(const u32x4*)(rb_ + 2048 + g * 128 + 64); \
        pre[3] = *(const u32x4*)(rb_ + 2560 + g * 128); pre[4] = *(const u32x4*)(rb_ + 2560 + g * 128 + 64); } } \
    { const int t_ = tp_ + step * (30 + (tid >> 6)); const int ln_ = tid & 63; \
      if (ln_ < 40 && t_ >= 0 && t_ < L) { \
        const int col_ = ln_ < 8 ? (1024 + h * 64 + ln_ * 8) : (ln_ < 24 ? (2048 + g * 128 + (ln_ - 8) * 8) : (2560 + g * 128 + (ln_ - 24) * 8)); \
        pre[5] = *(const u32x4*)(proj + (size_t)(row0 + t_) * 7232 + col_); } } }
  const int nch = L >> 5;
  u32x4 pre[6];
  SSD_PREFETCH(0);
  float psc0 = 0.f;
#define SSD_PREFSC(ci_) { if (tid < 32) { const int tp_ = dir == 0 ? (ci_) * 32 : L - 1 - (ci_) * 32; psc0 = small[(size_t)(row0 + tp_ + step * tid) * 64 + dir * 16 + h]; } }
  SSD_PREFSC(0);
  if (L > 256) __builtin_amdgcn_s_setprio(3);
  for (int ci = 0; ci < nch; ++ci) {
    const int tpos0 = dir == 0 ? ci * 32 : L - 1 - ci * 32;
    int tl_ = threadIdx.x;
    asm volatile("" : "+v"(tl_));
    const int tid = tl_, lane = tid & 63, w = tid >> 6, fr = lane & 15, fq = lane >> 4, rt = w & 1, ch = w >> 1, qd = tid >> 6;
    __syncthreads();
#pragma unroll
    for (int nt = 0; nt < 8; ++nt)
#pragma unroll
      for (int jj = 0; jj < 4; ++jj) PT[(16 * w + fq * 4 + jj) * 136 + nt * 16 + fr] = f2bf(accS[nt][jj]);
    if (w == 0) {
      float av = 0.f, dtv = 0.f;
      if (lane < 32) {
        dtv = softplusf(psc0 + dtb);
        av = dtv * Aneg;
      }
      const float cum = wave_incl_scan(av, lane);
      const float cl = __int_as_float(__builtin_amdgcn_readlane(__float_as_int(cum), 31));
      if (lane < 32) { sc[lane] = dtv; sc[32 + lane] = cum; sc[64 + lane] = __expf(cum); sc[96 + lane] = __expf(cl - cum); }
      if (lane == 31) sc[128] = __expf(cum);
    }
    {
      const int r5 = tid >> 3, c5 = (tid & 7) * 8;
#pragma unroll
      for (int u = 0; u < 5; ++u) *(u32x4*)(RAW + r5 * 320 + u * 64 + c5) = pre[u];
      const int ln = tid & 63;
      if (ln < 40) *(u32x4*)(RAW + (32 + (tid >> 6)) * 320 + ln * 8) = pre[5];
    }
    __syncthreads();
    float o1[32], o2[8];
    conv_chan<32, 320>(RAW + tid, wa0, wa1, wa2, wa3, wa4, ba, [&](int i, float v) { o1[i] = v; });
    conv_chan<8, 320>(RAW + qd * 8 * 320 + 256 + (tid & 63), wb0, wb1, wb2, wb3, wb4, bb, [&](int i, float v) { o2[i] = v; });
    bf16x8 hb[2][4];
#pragma unroll
    for (int t = 0; t < 2; ++t)
#pragma unroll
      for (int kk = 0; kk < 4; ++kk) hb[t][kk] = *(const bf16x8*)(PT + ((2 * ch + t) * 16 + fr) * 136 + kk * 32 + fq * 8);
    __syncthreads();
    if (tid < 64) {
#pragma unroll
      for (int i8 = 0; i8 < 4; ++i8) {
        u32x4 o_;
        o_.x = pack2(o1[i8 * 8 + 0] * sc[i8 * 8 + 0], o1[i8 * 8 + 1] * sc[i8 * 8 + 1]);
        o_.y = pack2(o1[i8 * 8 + 2] * sc[i8 * 8 + 2], o1[i8 * 8 + 3] * sc[i8 * 8 + 3]);
        o_.z = pack2(o1[i8 * 8 + 4] * sc[i8 * 8 + 4], o1[i8 * 8 + 5] * sc[i8 * 8 + 5]);
        o_.w = pack2(o1[i8 * 8 + 6] * sc[i8 * 8 + 6], o1[i8 * 8 + 7] * sc[i8 * 8 + 7]);
        *(u32x4*)(XT + tid * 40 + i8 * 8) = o_;
      }
    } else if (tid < 192) {
      const int n = tid - 64;
#pragma unroll
      for (int i = 0; i < 32; ++i) Bt[i * 136 + n] = f2bf(o1[i]);
#pragma unroll
      for (int i8 = 0; i8 < 4; ++i8) {
        u32x4 o_;
        o_.x = pack2(o1[i8 * 8 + 0] * sc[96 + i8 * 8 + 0], o1[i8 * 8 + 1] * sc[96 + i8 * 8 + 1]);
        o_.y = pack2(o1[i8 * 8 + 2] * sc[96 + i8 * 8 + 2], o1[i8 * 8 + 3] * sc[96 + i8 * 8 + 3]);
        o_.z = pack2(o1[i8 * 8 + 4] * sc[96 + i8 * 8 + 4], o1[i8 * 8 + 5] * sc[96 + i8 * 8 + 5]);
        o_.w = pack2(o1[i8 * 8 + 6] * sc[96 + i8 * 8 + 6], o1[i8 * 8 + 7] * sc[96 + i8 * 8 + 7]);
        *(u32x4*)(BdT + n * 40 + i8 * 8) = o_;
      }
    } else {
      const int n = tid - 192;
#pragma unroll
      for (int i = 0; i < 32; ++i) Ct[i * 136 + n] = f2bf(o1[i]);
    }
#pragma unroll
    for (int e = 0; e < 8; ++e) Ct[(qd * 8 + e) * 136 + 64 + (tid & 63)] = f2bf(o2[e]);
    __syncthreads();
    if (ci + 1 < nch) { SSD_PREFETCH(ci + 1); SSD_PREFSC(ci + 1); }
    f32x4 G = (f32x4){0.f, 0.f, 0.f, 0.f};
    f32x4 Y[2];
    Y[0] = (f32x4){0.f, 0.f, 0.f, 0.f}; Y[1] = (f32x4){0.f, 0.f, 0.f, 0.f};
#pragma unroll
    for (int kk = 0; kk < 4; ++kk) {
      const bf16x8 ca = *(const bf16x8*)(Ct + (16 * rt + fr) * 136 + kk * 32 + fq * 8);
      const bf16x8 bbv = *(const bf16x8*)(Bt + (16 * ch + fr) * 136 + kk * 32 + fq * 8);
      G = __builtin_amdgcn_mfma_f32_16x16x32_bf16(ca, bbv, G, 0, 0, 0);
      Y[0] = __builtin_amdgcn_mfma_f32_16x16x32_bf16(ca, hb[0][kk], Y[0], 0, 0, 0);
      Y[1] = __builtin_amdgcn_mfma_f32_16x16x32_bf16(ca, hb[1][kk], Y[1], 0, 0, 0);
    }
#pragma unroll
    for (int jj = 0; jj < 4; ++jj) {
      const int i = 16 * rt + fq * 4 + jj;
      const int j = 16 * ch + fr;
      float sv = (j <= i) ? G[jj] * __expf(sc[32 + i] - sc[32 + j]) : 0.f;
      if (dir == 0 && j == i) sv += Dh * __builtin_amdgcn_rcpf(fmaxf(sc[i], 1e-30f));
      SCR[i * 40 + j] = f2bf(sv);
      const float ec = sc[64 + i];
      Y[0][jj] *= ec; Y[1][jj] *= ec;
    }
    __syncthreads();
    {
      const bf16x8 sa = *(const bf16x8*)(SCR + (16 * rt + fr) * 40 + fq * 8);
#pragma unroll
      for (int t = 0; t < 2; ++t) {
        const bf16x8 xb = *(const bf16x8*)(XT + ((2 * ch + t) * 16 + fr) * 40 + fq * 8);
        Y[t] = __builtin_amdgcn_mfma_f32_16x16x32_bf16(sa, xb, Y[t], 0, 0, 0);
      }
    }
#pragma unroll
    for (int jj = 0; jj < 4; ++jj) {
      const int i = 16 * rt + fq * 4 + jj;
      const int t = tpos0 + step * i;
#pragma unroll
      for (int u = 0; u < 2; ++u) Pout[(size_t)(row0 + t) * 2048 + h * 64 + (2 * ch + u) * 16 + fr] = f2bf(Y[u][jj]);
    }
    {
      const float el = sc[128];
      const bf16x8 xa = *(const bf16x8*)(XT + (16 * w + fr) * 40 + fq * 8);
#pragma unroll
      for (int nt = 0; nt < 8; ++nt) {
        accS[nt] *= el;
        const bf16x8 bd = *(const bf16x8*)(BdT + (nt * 16 + fr) * 40 + fq * 8);
        accS[nt] = __builtin_amdgcn_mfma_f32_16x16x32_bf16(xa, bd, accS[nt], 0, 0, 0);
      }
    }
  }
  __builtin_amdgcn_s_setprio(0);
#undef SSD_PREFETCH
#undef SSD_PREFSC
  if (seq < 32) {
    float* so = p.out + OUT_SSD + ((size_t)((seq * 2 + dir) * 16 + h)) * 8192;
#pragma unroll
    for (int nt = 0; nt < 8; ++nt)
#pragma unroll
      for (int jj = 0; jj < 4; ++jj) so[(16 * w + fq * 4 + jj) * 128 + nt * 16 + fr] = accS[nt][jj];
  }
}

__device__ __forceinline__ void dn_item(const Params& p, int seq, int dir, int h, int half, unsigned char* smem) {
  const int tid = threadIdx.x, lane = tid & 63, w = tid >> 6, fr = lane & 15, fq = lane >> 4;
  const int rt = w & 1, ch = w >> 1;
  bf16_t* RQ = (bf16_t*)smem;
  bf16_t* RK = (bf16_t*)(smem + 8704);
  bf16_t* RS = (bf16_t*)(smem + 17408);
  bf16_t* RE = (bf16_t*)(smem + 34816);
  unsigned char* RAb = smem + 45056;
  bf16_t* RW = (bf16_t*)(smem + 49664);
  float* RU = (float*)(smem + 58368);
  bf16_t* RV = (bf16_t*)(smem + 66688);
  float* sc = (float*)(smem + 71808);
  bf16_t* RAWKV = RW;
  bf16_t* RAWQ = RE;
  const int L = seq < 32 ? 256 : 2048;
  const int row0 = seq < 32 ? seq * 256 : TP + (seq - 32) * 2048;
  const bf16_t* proj = (const bf16_t*)(p.ws + OFF_B);
  const float* small = (const float*)(p.ws + OFF_SMALL);
  bf16_t* Pout = dir == 0 ? (bf16_t*)(p.ws + OFF_PF) : (bf16_t*)p.out;
  const float Aneg = -expf(p.in[38][dir * 8 + h]);
  const float dtb = p.in[37][dir * 8 + h];
  const int step = dir == 0 ? 1 : -1;
  const bool isk = tid < 128, isv = tid >= 128 && tid < 192;
  const int wc1 = isk ? (1024 + h * 128 + tid) : (2048 + h * 128 + half * 64 + ((tid - 128) & 63));
  const int wc2 = h * 128 + (tid & 127);
  float wa0, wa1, wa2, wa3, wa4, wb0, wb1, wb2, wb3, wb4;
  {
    const float* cw = p.in[36];
    const float t0 = cw[0 * 3072 + wc1], t1 = cw[1 * 3072 + wc1], t2 = cw[2 * 3072 + wc1], t3 = cw[3 * 3072 + wc1], t4 = cw[4 * 3072 + wc1];
    wa0 = dir ? t4 : t0; wa1 = dir ? t3 : t1; wa2 = t2; wa3 = dir ? t1 : t3; wa4 = dir ? t0 : t4;
    const float u0 = cw[0 * 3072 + wc2], u1 = cw[1 * 3072 + wc2], u2 = cw[2 * 3072 + wc2], u3 = cw[3 * 3072 + wc2], u4 = cw[4 * 3072 + wc2];
    wb0 = dir ? u4 : u0; wb1 = dir ? u3 : u1; wb2 = u2; wb3 = dir ? u1 : u3; wb4 = dir ? u0 : u4;
  }
  const int qhalf = tid >> 7;
  f32x4 accS[2][4];
  if (seq < 32) {
#pragma unroll
    for (int m = 0; m < 2; ++m)
#pragma unroll
      for (int n = 0; n < 4; ++n) accS[m][n] = (f32x4){0.f, 0.f, 0.f, 0.f};
  } else {
    const float* s0 = p.in[3] + ((size_t)(((seq - 32) * 2 + dir) * 8 + h)) * 16384 + half * 64;
#pragma unroll
    for (int m = 0; m < 2; ++m)
#pragma unroll
      for (int n = 0; n < 4; ++n)
#pragma unroll
        for (int jj = 0; jj < 4; ++jj) accS[m][n][jj] = s0[(32 * w + m * 16 + fq * 4 + jj) * 128 + n * 16 + fr];
  }
#define DN_PREFETCH(ci_) { const int tp_ = dir == 0 ? (ci_) * 32 : L - 1 - (ci_) * 32; \
    _Pragma("unroll") for (int u = 0; u < 6; ++u) pre[u] = (u32x4){0u, 0u, 0u, 0u}; \
    { const int t_ = tp_ + step * ((tid >> 3) - 2); \
      if (t_ >= 0 && t_ < L) { const bf16_t* rb_ = proj + (size_t)(row0 + t_) * 7232 + 3104 + h * 128 + (tid & 7) * 8; \
        pre[0] = *(const u32x4*)(rb_ + 1024); pre[1] = *(const u32x4*)(rb_ + 1024 + 64); pre[2] = *(const u32x4*)(rb_ + 2048 + half * 64); \
        pre[3] = *(const u32x4*)(rb_); pre[4] = *(const u32x4*)(rb_ + 64); } } \
    { const int t_ = tp_ + step * (30 + (tid >> 6)); const int ln_ = tid & 63; \
      if (ln_ < 40 && t_ >= 0 && t_ < L) { \
        const int col_ = 3104 + h * 128 + (ln_ < 16 ? (1024 + ln_ * 8) : (ln_ < 24 ? (2048 + half * 64 + (ln_ - 16) * 8) : ((ln_ - 24) * 8))); \
        pre[5] = *(const u32x4*)(proj + (size_t)(row0 + t_) * 7232 + col_); } } }
  const int nch = L >> 5;
  u32x4 pre[6];
  DN_PREFETCH(0);
  float psc0 = 0.f, psc1 = 0.f;
#define DN_PREFSC(ci_) { if (tid < 32) { const int tp_ = dir == 0 ? (ci_) * 32 : L - 1 - (ci_) * 32; const float* sm_ = small + (size_t)(row0 + tp_ + step * tid) * 64; \
    psc0 = sm_[32 + dir * 8 + h]; psc1 = sm_[48 + dir * 8 + h]; } }
  DN_PREFSC(0);
  if (L > 256) __builtin_amdgcn_s_setprio(3);
  for (int ci = 0; ci < nch; ++ci) {
    const int tpos0 = dir == 0 ? ci * 32 : L - 1 - ci * 32;
    int tl_ = threadIdx.x;
    asm volatile("" : "+v"(tl_));
    const int tid = tl_, lane = tid & 63, w = tid >> 6, fr = lane & 15, fq = lane >> 4, rt = w & 1, ch = w >> 1, qhalf = tid >> 7;
    const bool isk = tid < 128, isv = tid >= 128 && tid < 192;
    __syncthreads();
#pragma unroll
    for (int m = 0; m < 2; ++m)
#pragma unroll
      for (int n = 0; n < 4; ++n)
        { u32x2 o_; o_.x = pack2(accS[m][n][0], accS[m][n][1]); o_.y = pack2(accS[m][n][2], accS[m][n][3]);
          *(u32x2*)(RS + (n * 16 + fr) * 136 + 32 * w + m * 16 + fq * 4) = o_; }
    if (w == 0) {
      float gi = 0.f, be = 0.f;
      if (lane < 32) {
        gi = Aneg * softplusf(psc0 + dtb);
        be = __builtin_amdgcn_rcpf(1.f + __expf(-psc1));
      }
      const float gcs = wave_incl_scan(gi, lane);
      const float gl = __int_as_float(__builtin_amdgcn_readlane(__float_as_int(gcs), 31));
      if (lane < 32) { sc[lane] = gcs; sc[32 + lane] = __expf(gcs); sc[64 + lane] = be; sc[160 + lane] = __expf(gl - gcs); }
      if (lane == 31) sc[224] = __expf(gcs);
    }
    {
      const int r5 = tid >> 3, c5 = (tid & 7) * 8;
      *(u32x4*)(RAWKV + r5 * 192 + c5) = pre[0];
      *(u32x4*)(RAWKV + r5 * 192 + 64 + c5) = pre[1];
      *(u32x4*)(RAWKV + r5 * 192 + 128 + c5) = pre[2];
      *(u32x4*)(RAWQ + r5 * 128 + c5) = pre[3];
      *(u32x4*)(RAWQ + r5 * 128 + 64 + c5) = pre[4];
      const int r6 = 32 + (tid >> 6), ln = tid & 63;
      if (ln < 24) *(u32x4*)(RAWKV + r6 * 192 + ln * 8) = pre[5];
      else if (ln < 40) *(u32x4*)(RAWQ + r6 * 128 + (ln - 24) * 8) = pre[5];
    }
    __syncthreads();
    f32v2 kvp[16];
#define KV(i_) kvp[(i_) >> 1][(i_) & 1]
    if (tid < 192) conv_chan<32, 192>(RAWKV + tid, wa0, wa1, wa2, wa3, wa4, 0.f, [&](int i, float v) { KV(i) = v; });
    if (isk) {
#pragma unroll
      for (int i = 0; i < 32; ++i) RK[i * 136 + tid] = f2bf(KV(i));
    }
    conv_chan<16, 128>(RAWQ + qhalf * 16 * 128 + (tid & 127), wb0, wb1, wb2, wb3, wb4, 0.f,
                       [&](int i, float v) { RQ[(qhalf * 16 + i) * 136 + (tid & 127)] = f2bf(v); });
    __syncthreads();
    {
      const int i = tid >> 3, isk_ = (tid >> 2) & 1, qr = tid & 3;
      const bf16_t* src = (isk_ ? RK : RQ) + i * 136 + qr * 32;
      float ss = 0.f;
#pragma unroll
      for (int c = 0; c < 4; ++c) {
        const u32x4 x = *(const u32x4*)(src + c * 8);
        ss += bflo(x.x) * bflo(x.x) + bfhi(x.x) * bfhi(x.x) + bflo(x.y) * bflo(x.y) + bfhi(x.y) * bfhi(x.y)
            + bflo(x.z) * bflo(x.z) + bfhi(x.z) * bfhi(x.z) + bflo(x.w) * bflo(x.w) + bfhi(x.w) * bfhi(x.w);
      }
      ss += dppf<0xB1>(ss); ss += dppf<0x4E>(ss);
      if (qr == 0) {
        const float rr = rsqrtf(ss + 1e-6f);
        if (isk_) { sc[128 + i] = rr; sc[192 + i] = sc[64 + i] * sc[32 + i] * rr; }
        else sc[96 + i] = rr * 0.08838834764831845f;
      }
    }
    __syncthreads();
    if (ci + 1 < nch) { DN_PREFETCH(ci + 1); DN_PREFSC(ci + 1); }
    f32x4 QK = (f32x4){0.f, 0.f, 0.f, 0.f};
    {
      f32x4 KK = (f32x4){0.f, 0.f, 0.f, 0.f};
#pragma unroll
      for (int kk = 0; kk < 4; ++kk) {
        const bf16x8 qa0 = *(const bf16x8*)(RQ + (16 * rt + fr) * 136 + kk * 32 + fq * 8);
        const bf16x8 ka = *(const bf16x8*)(RK + (16 * rt + fr) * 136 + kk * 32 + fq * 8);
        const bf16x8 kb = *(const bf16x8*)(RK + (16 * ch + fr) * 136 + kk * 32 + fq * 8);
        KK = __builtin_amdgcn_mfma_f32_16x16x32_bf16(ka, kb, KK, 0, 0, 0);
        QK = __builtin_amdgcn_mfma_f32_16x16x32_bf16(qa0, kb, QK, 0, 0, 0);
      }
      float* Am = (float*)RAb;
      const int j = 16 * ch + fr;
      const float gj = sc[j], rkj = sc[128 + j];
#pragma unroll
      for (int jj = 0; jj < 4; ++jj) {
        const int i = 16 * rt + fq * 4 + jj;
        const float dec = __expf(sc[i] - gj);
        Am[j * 36 + i] = (j < i) ? sc[64 + i] * sc[128 + i] * rkj * dec * KK[jj] : 0.f;
        QK[jj] = (j <= i) ? sc[96 + i] * rkj * dec * QK[jj] : 0.f;
      }
    }
    __syncthreads();
#pragma unroll
    for (int u = 0; u < 2; ++u) {
      const int idx = tid + 256 * u;
      const int j = idx & 31, kd8 = idx >> 5;
      const u32x4 kx = *(const u32x4*)(RK + j * 136 + kd8 * 8);
      const float s = sc[128 + j] * sc[160 + j];
      RE[(kd8 * 8 + 0) * 40 + j] = f2bf(bflo(kx.x) * s); RE[(kd8 * 8 + 1) * 40 + j] = f2bf(bfhi(kx.x) * s);
      RE[(kd8 * 8 + 2) * 40 + j] = f2bf(bflo(kx.y) * s); RE[(kd8 * 8 + 3) * 40 + j] = f2bf(bfhi(kx.y) * s);
      RE[(kd8 * 8 + 4) * 40 + j] = f2bf(bflo(kx.z) * s); RE[(kd8 * 8 + 5) * 40 + j] = f2bf(bfhi(kx.z) * s);
      RE[(kd8 * 8 + 6) * 40 + j] = f2bf(bflo(kx.w) * s); RE[(kd8 * 8 + 7) * 40 + j] = f2bf(bfhi(kx.w) * s);
    }
    if (tid < 192) {
      const float* Am = (const float*)RAb;
      const float* rs = isk ? (sc + 192) : (sc + 64);
#pragma unroll
      for (int i = 0; i < 16; ++i) kvp[i] *= (f32v2){rs[2 * i], rs[2 * i + 1]};
#pragma unroll
      for (int j = 0; j < 31; ++j) {
        const float xj = KV(j);
        int off = j * 36;
        asm volatile("" : "+v"(off) : "v"(xj));
        const f32v2 xx = (f32v2){xj, xj};
#pragma unroll
        for (int q = (j + 1) >> 2; q < 8; ++q) {
          const float4 a = *(const float4*)(Am + off + q * 4);
          kvp[2 * q] -= (f32v2){a.x, a.y} * xx;
          kvp[2 * q + 1] -= (f32v2){a.z, a.w} * xx;
        }
      }
    }
    if (isk) {
#pragma unroll
      for (int i = 0; i < 32; ++i) RW[i * 136 + tid] = f2bf(KV(i));
    } else if (isv) {
#pragma unroll
      for (int i = 0; i < 32; ++i) RU[i * 65 + (tid - 128)] = KV(i);
    }
    __syncthreads();
    f32x4 O[2], VN[2];
    O[0] = (f32x4){0.f, 0.f, 0.f, 0.f}; O[1] = O[0]; VN[0] = O[0]; VN[1] = O[0];
#pragma unroll
    for (int kk = 0; kk < 4; ++kk) {
      const bf16x8 wa = *(const bf16x8*)(RW + (16 * rt + fr) * 136 + kk * 32 + fq * 8);
      const bf16x8 qa1 = *(const bf16x8*)(RQ + (16 * rt + fr) * 136 + kk * 32 + fq * 8);
#pragma unroll
      for (int t = 0; t < 2; ++t) {
        const bf16x8 sb = *(const bf16x8*)(RS + ((2 * ch + t) * 16 + fr) * 136 + kk * 32 + fq * 8);
        VN[t] = __builtin_amdgcn_mfma_f32_16x16x32_bf16(wa, sb, VN[t], 0, 0, 0);
        O[t] = __builtin_amdgcn_mfma_f32_16x16x32_bf16(qa1, sb, O[t], 0, 0, 0);
      }
    }
    {
      bf16_t* QKd = (bf16_t*)RAb;
#pragma unroll
      for (int jj = 0; jj < 4; ++jj) {
        const int i = 16 * rt + fq * 4 + jj;
        const float osc = sc[96 + i] * sc[32 + i];
#pragma unroll
        for (int t = 0; t < 2; ++t) {
          const int v = (2 * ch + t) * 16 + fr;
          const float vn = RU[i * 65 + v] - VN[t][jj];
          O[t][jj] *= osc;
          RV[v * 40 + i] = f2bf(vn);
        }
        QKd[i * 40 + 16 * ch + fr] = f2bf(QK[jj]);
      }
    }
    __syncthreads();
    {
      const bf16_t* QKd = (const bf16_t*)RAb;
      const float el = sc[224];
      const bf16x8 pa = *(const bf16x8*)(QKd + (16 * rt + fr) * 40 + fq * 8);
      bf16x8 vb[4];
#pragma unroll
      for (int n = 0; n < 4; ++n) vb[n] = *(const bf16x8*)(RV + (n * 16 + fr) * 40 + fq * 8);
#pragma unroll
      for (int t = 0; t < 2; ++t) O[t] = __builtin_amdgcn_mfma_f32_16x16x32_bf16(pa, (ch == 0 ? vb[t] : vb[2 + t]), O[t], 0, 0, 0);
#pragma unroll
      for (int m = 0; m < 2; ++m) {
        const bf16x8 ke = *(const bf16x8*)(RE + (32 * w + m * 16 + fr) * 40 + fq * 8);
#pragma unroll
        for (int n = 0; n < 4; ++n) {
          accS[m][n] *= el;
          accS[m][n] = __builtin_amdgcn_mfma_f32_16x16x32_bf16(ke, vb[n], accS[m][n], 0, 0, 0);
        }
      }
#pragma unroll
      for (int jj = 0; jj < 4; ++jj) {
        const int i = 16 * rt + fq * 4 + jj;
        const int t = tpos0 + step * i;
#pragma unroll
        for (int u = 0; u < 2; ++u) Pout[(size_t)(row0 + t) * 2048 + 1024 + h * 128 + half * 64 + (2 * ch + u) * 16 + fr] = f2bf(O[u][jj]);
      }
    }
  }
  __builtin_amdgcn_s_setprio(0);
#undef KV
#undef DN_PREFETCH
#undef DN_PREFSC
  if (seq < 32) {
    float* so = p.out + OUT_DN + ((size_t)((seq * 2 + dir) * 8 + h)) * 16384 + half * 64;
#pragma unroll
    for (int m = 0; m < 2; ++m)
#pragma unroll
      for (int n = 0; n < 4; ++n)
#pragma unroll
        for (int jj = 0; jj < 4; ++jj) so[(32 * w + m * 16 + fq * 4 + jj) * 128 + n * 16 + fr] = accS[m][n][jj];
  }
}

__device__ __forceinline__ void scan_phase(const Params& p, unsigned char* smem) {
  const int nb = gridDim.x, b = blockIdx.x;
  constexpr int NITEM = 2176;
  int first, step;
  if (b < 128) { first = b; step = NITEM; } else { first = b; step = nb - 128; }
  for (int rep_ = 0; rep_ < ((b < 128 && PROBE_LONG2) ? 2 : 1); ++rep_)
  for (int item = first; item < NITEM; item += step) {
    const bool isdn = item < 64 || (item >= 128 && item < 1152);
    if (!isdn) continue;
    const int i = item < 64 ? ((item & 7) * 8 + (item >> 3)) : item - 128;
    const int seq = item < 64 ? 32 + i / 32 : i / 32;
    dn_item(p, seq, (i >> 4) & 1, (i >> 1) & 7, i & 1, smem);
  }
  for (int rep_ = 0; rep_ < ((b < 128 && PROBE_LONG2) ? 2 : 1); ++rep_)
  for (int item = first; item < NITEM; item += step) {
    const bool isdn = item < 64 || (item >= 128 && item < 1152);
    if (isdn) continue;
    const int i = item < 128 ? (((item - 64) & 7) * 8 + ((item - 64) >> 3)) : item - 1152;
    const int seq = item < 128 ? 32 + i / 32 : i / 32;
    ssd_item(p, seq, (i >> 4) & 1, i & 15, smem);
  }
}

__device__ __forceinline__ void combine0_phase(const Params& p) {
  const int lane = threadIdx.x & 63, w = threadIdx.x >> 6;
  bf16_t* Pf = (bf16_t*)(p.ws + OFF_PF);
  const bf16_t* Pb = (const bf16_t*)p.out;
  const bf16_t* proj = (const bf16_t*)(p.ws + OFF_B);
  for (int row = blockIdx.x * 4 + w; row < TTOK; row += gridDim.x * 4) {
    const int c = lane * 16;
    {
      u32x4 f[2], bq[2], z[2];
      f[0] = *(const u32x4*)(Pf + (size_t)row * 2048 + c); f[1] = *(const u32x4*)(Pf + (size_t)row * 2048 + c + 8);
      bq[0] = *(const u32x4*)(Pb + (size_t)row * 2048 + c); bq[1] = *(const u32x4*)(Pb + (size_t)row * 2048 + c + 8);
      z[0] = *(const u32x4*)(proj + (size_t)row * 7232 + c); z[1] = *(const u32x4*)(proj + (size_t)row * 7232 + c + 8);
      const unsigned* fu = (const unsigned*)f; const unsigned* bu = (const unsigned*)bq; const unsigned* zu = (const unsigned*)z;
      float y[16]; float ss = 0.f;
#pragma unroll
      for (int e = 0; e < 8; ++e) {
        y[2 * e] = (bflo(fu[e]) + bflo(bu[e])) * siluf(bflo(zu[e]));
        y[2 * e + 1] = (bfhi(fu[e]) + bfhi(bu[e])) * siluf(bfhi(zu[e]));
        ss += y[2 * e] * y[2 * e] + y[2 * e + 1] * y[2 * e + 1];
      }
      ss = wsum(ss);
      const float rstd = rsqrtf(ss * (1.f / 1024.f) + 1e-6f);
      const float* nw = p.in[35] + c;
      u32x4 o[2]; unsigned* ou = (unsigned*)o;
#pragma unroll
      for (int e = 0; e < 8; ++e) ou[e] = pack2(y[2 * e] * rstd * nw[2 * e], y[2 * e + 1] * rstd * nw[2 * e + 1]);
      *(u32x4*)(Pf + (size_t)row * 2048 + c) = o[0]; *(u32x4*)(Pf + (size_t)row * 2048 + c + 8) = o[1];
    }
    {
      u32x4 f[2], bq[2], g[2];
      f[0] = *(const u32x4*)(Pf + (size_t)row * 2048 + 1024 + c); f[1] = *(const u32x4*)(Pf + (size_t)row * 2048 + 1024 + c + 8);
      bq[0] = *(const u32x4*)(Pb + (size_t)row * 2048 + 1024 + c); bq[1] = *(const u32x4*)(Pb + (size_t)row * 2048 + 1024 + c + 8);
      g[0] = *(const u32x4*)(proj + (size_t)row * 7232 + 6176 + c); g[1] = *(const u32x4*)(proj + (size_t)row * 7232 + 6176 + c + 8);
      const unsigned* fu = (const unsigned*)f; const unsigned* bu = (const unsigned*)bq; const unsigned* gu = (const unsigned*)g;
      float y[16]; float ss = 0.f;
#pragma unroll
      for (int e = 0; e < 8; ++e) {
        y[2 * e] = bflo(fu[e]) + bflo(bu[e]);
        y[2 * e + 1] = bfhi(fu[e]) + bfhi(bu[e]);
        ss += y[2 * e] * y[2 * e] + y[2 * e + 1] * y[2 * e + 1];
      }
      ss += dppf<0xB1>(ss); ss += dppf<0x4E>(ss); ss += dppf<0x141>(ss);
      const float rstd = rsqrtf(ss * (1.f / 128.f) + 1e-6f);
      const float* nw = p.in[39] + (c & 127);
      u32x4 o[2]; unsigned* ou = (unsigned*)o;
#pragma unroll
      for (int e = 0; e < 8; ++e)
        ou[e] = pack2(y[2 * e] * rstd * nw[2 * e] * siluf(bflo(gu[e])), y[2 * e + 1] * rstd * nw[2 * e + 1] * siluf(bfhi(gu[e])));
      *(u32x4*)(Pf + (size_t)row * 2048 + 1024 + c) = o[0]; *(u32x4*)(Pf + (size_t)row * 2048 + 1024 + c + 8) = o[1];
    }
  }
}

__device__ __forceinline__ void convact_phase(const Params& p, int layer) {
  const float* cw = p.in[layer == 0 ? 15 : 25];
  const float* cb = p.in[layer == 0 ? 16 : 26];
  const bf16_t* up = (const bf16_t*)(p.ws + OFF_C);
  bf16_t* act = (bf16_t*)(p.ws + OFF_ACT);
  const int total = (TTOK / 8) * 352;
  for (int u = blockIdx.x * NT + threadIdx.x; u < total; u += gridDim.x * NT) {
    const int rb = u / 352, j = (u % 352) * 8;
    float wa[3][8], wb[3][8], ba[8], bb[8];
#pragma unroll
    for (int t = 0; t < 3; ++t) {
#pragma unroll
      for (int e = 0; e < 8; e += 4) {
        const float4 x = *(const float4*)(cw + t * 5632 + j + e);
        wa[t][e] = x.x; wa[t][e + 1] = x.y; wa[t][e + 2] = x.z; wa[t][e + 3] = x.w;
        const float4 y = *(const float4*)(cw + t * 5632 + 2816 + j + e);
        wb[t][e] = y.x; wb[t][e + 1] = y.y; wb[t][e + 2] = y.z; wb[t][e + 3] = y.w;
      }
    }
#pragma unroll
    for (int e = 0; e < 8; e += 4) {
      const float4 x = *(const float4*)(cb + j + e);
      ba[e] = x.x; ba[e + 1] = x.y; ba[e + 2] = x.z; ba[e + 3] = x.w;
      const float4 y = *(const float4*)(cb + 2816 + j + e);
      bb[e] = y.x; bb[e + 1] = y.y; bb[e + 2] = y.z; bb[e + 3] = y.w;
    }
    const int T0 = rb * 8;
    int t0, L;
    if (T0 < TP) { t0 = T0 & 255; L = 256; } else { t0 = (T0 - TP) & 2047; L = 2048; }
    float pa[8], pb[8], ca[8], cbv[8], na[8], nbv[8];
    const u32x4 zero4 = (u32x4){0u, 0u, 0u, 0u};
    {
      u32x4 xa = zero4, xb = zero4;
      if (t0 > 0) { xa = *(const u32x4*)(up + (size_t)(T0 - 1) * 5632 + j); xb = *(const u32x4*)(up + (size_t)(T0 - 1) * 5632 + 2816 + j); }
      const unsigned* ua = (const unsigned*)&xa; const unsigned* ub = (const unsigned*)&xb;
#pragma unroll
      for (int e = 0; e < 4; ++e) { pa[2 * e] = bflo(ua[e]); pa[2 * e + 1] = bfhi(ua[e]); pb[2 * e] = bflo(ub[e]); pb[2 * e + 1] = bfhi(ub[e]); }
      xa = *(const u32x4*)(up + (size_t)T0 * 5632 + j); xb = *(const u32x4*)(up + (size_t)T0 * 5632 + 2816 + j);
#pragma unroll
      for (int e = 0; e < 4; ++e) { ca[2 * e] = bflo(ua[e]); ca[2 * e + 1] = bfhi(ua[e]); cbv[2 * e] = bflo(ub[e]); cbv[2 * e + 1] = bfhi(ub[e]); }
    }
#pragma unroll
    for (int r = 0; r < 8; ++r) {
      u32x4 xa = zero4, xb = zero4;
      if (t0 + r + 1 < L) { xa = *(const u32x4*)(up + (size_t)(T0 + r + 1) * 5632 + j); xb = *(const u32x4*)(up + (size_t)(T0 + r + 1) * 5632 + 2816 + j); }
      const unsigned* ua = (const unsigned*)&xa; const unsigned* ub = (const unsigned*)&xb;
#pragma unroll
      for (int e = 0; e < 4; ++e) { na[2 * e] = bflo(ua[e]); na[2 * e + 1] = bfhi(ua[e]); nbv[2 * e] = bflo(ub[e]); nbv[2 * e + 1] = bfhi(ub[e]); }
      float o[8];
#pragma unroll
      for (int e = 0; e < 8; ++e) {
        const float a = pa[e] * wa[0][e] + ca[e] * wa[1][e] + na[e] * wa[2][e] + ba[e];
        const float b = pb[e] * wb[0][e] + cbv[e] * wb[1][e] + nbv[e] * wb[2][e] + bb[e];
        o[e] = siluf(a) * b;
        pa[e] = ca[e]; ca[e] = na[e]; pb[e] = cbv[e]; cbv[e] = nbv[e];
      }
      u32x4 ov; ov.x = pack2(o[0], o[1]); ov.y = pack2(o[2], o[3]); ov.z = pack2(o[4], o[5]); ov.w = pack2(o[6], o[7]);
      *(u32x4*)(act + (size_t)(T0 + r) * 2816 + j) = ov;
    }
  }
}

__device__ __forceinline__ void lnstat_rows(const Params& p) {
  const int lane = threadIdx.x & 63, w = threadIdx.x >> 6;
  const bf16_t* proj = (const bf16_t*)(p.ws + OFF_C);
  float* stat = (float*)(p.ws + OFF_SMALL);
  for (int row = blockIdx.x * 4 + w; row < TTOK; row += gridDim.x * 4) {
    const bf16_t* src = proj + (size_t)row * 3584 + 1024 + lane * 16;
    const u32x4 x0 = *(const u32x4*)src, x1 = *(const u32x4*)(src + 8);
    float v[16];
    v[0] = bflo(x0.x); v[1] = bfhi(x0.x); v[2] = bflo(x0.y); v[3] = bfhi(x0.y); v[4] = bflo(x0.z); v[5] = bfhi(x0.z); v[6] = bflo(x0.w); v[7] = bfhi(x0.w);
    v[8] = bflo(x1.x); v[9] = bfhi(x1.x); v[10] = bflo(x1.y); v[11] = bfhi(x1.y); v[12] = bflo(x1.z); v[13] = bfhi(x1.z); v[14] = bflo(x1.w); v[15] = bfhi(x1.w);
    float sm = 0.f;
#pragma unroll
    for (int e = 0; e < 16; ++e) sm += v[e];
    const float mean = wsum(sm) * (1.f / 1024.f);
    float q = 0.f;
#pragma unroll
    for (int e = 0; e < 16; ++e) { const float d = v[e] - mean; q += d * d; }
    const float var = wsum(q) * (1.f / 1024.f);
    if (lane == 0) { stat[row * 2] = mean; stat[row * 2 + 1] = rsqrtf(var + 1e-6f); }
  }
}

__device__ __forceinline__ void gate_item(const Params& p, int item, unsigned char* smem) {
  bf16_t* Gt = (bf16_t*)smem;
  const int tid = threadIdx.x, lane = tid & 63, w = tid >> 6, fr = lane & 15, fq = lane >> 4;
  const int ch = item >> 3, g = (item >> 1) & 3, dh = item & 1;
  const int T0 = ch * 128;
  const bf16_t* proj = (const bf16_t*)(p.ws + OFF_C);
  bf16_t* mixed = (bf16_t*)(p.ws + OFF_PF);
  const bf16_t* Wsb = (const bf16_t*)(p.ws + OFF_WSB);
  const float* stat = (const float*)(p.ws + OFF_SMALL);
  const int cb0 = g * 256 + dh * 128;
  __syncthreads();
#pragma unroll
  for (int i = 0; i < 8; ++i) {
    const int idx = tid + 256 * i;
    const int j = idx >> 4, d8 = idx & 15;
    const int cbase = cb0 + d8 * 8;
    const u32x4 x = *(const u32x4*)(proj + (size_t)(T0 + j) * 3584 + 1024 + cbase);
    const unsigned* xu = (const unsigned*)&x;
    const float mean = stat[(T0 + j) * 2], rstd = stat[(T0 + j) * 2 + 1];
    const float* lw = p.in[42] + cbase; const float* lb = p.in[43] + cbase;
    const int jc = (((j >> 3) ^ d8) << 3) + (j & 7);
#pragma unroll
    for (int e = 0; e < 4; ++e) {
      const float a = (bflo(xu[e]) - mean) * rstd * lw[2 * e] + lb[2 * e];
      const float b = (bfhi(xu[e]) - mean) * rstd * lw[2 * e + 1] + lb[2 * e + 1];
      Gt[(d8 * 8 + 2 * e) * 136 + jc] = f2bf(a);
      Gt[(d8 * 8 + 2 * e + 1) * 136 + jc] = f2bf(b);
    }
  }
  __syncthreads();
  f32x4 acc[2][8];
#pragma unroll
  for (int m = 0; m < 2; ++m)
#pragma unroll
    for (int n = 0; n < 8; ++n) acc[m][n] = (f32x4){0.f, 0.f, 0.f, 0.f};
#pragma unroll
  for (int kk = 0; kk < 4; ++kk) {
    bf16x8 a[2];
#pragma unroll
    for (int m = 0; m < 2; ++m) a[m] = *(const bf16x8*)(Wsb + g * 16384 + (w * 32 + m * 16 + fr) * 128 + kk * 32 + fq * 8);
#pragma unroll
    for (int n = 0; n < 8; ++n) {
      const int d = n * 16 + fr;
      const bf16x8 b = *(const bf16x8*)(Gt + d * 136 + (((kk * 4 + fq) ^ (d >> 3)) << 3));
#pragma unroll
      for (int m = 0; m < 2; ++m) acc[m][n] = __builtin_amdgcn_mfma_f32_16x16x32_bf16(b, a[m], acc[m][n], 0, 0, 0);
    }
  }
  __syncthreads();
  float* Ow = (float*)smem + w * 4224;
#pragma unroll
  for (int m = 0; m < 2; ++m) {
    const float bias = p.in[45][g * 128 + w * 32 + m * 16 + fr];
#pragma unroll
    for (int n = 0; n < 8; ++n)
      *(float4*)(Ow + (m * 16 + fr) * 132 + n * 16 + fq * 4) = make_float4(acc[m][n][0] + bias, acc[m][n][1] + bias, acc[m][n][2] + bias, acc[m][n][3] + bias);
  }
  asm volatile("s_waitcnt lgkmcnt(0)" ::: "memory");
#pragma unroll
  for (int i = 0; i < 8; ++i) {
    const int r = i * 4 + (lane >> 4), c8 = (lane & 15) * 8;
    const float4 s0 = *(const float4*)(Ow + r * 132 + c8), s1 = *(const float4*)(Ow + r * 132 + c8 + 4);
    const size_t T = (size_t)(T0 + w * 32 + r);
    const u32x4 u = *(const u32x4*)(proj + T * 3584 + cb0 + c8);
    u32x4 o;
    o.x = pack2(bflo(u.x) * s0.x, bfhi(u.x) * s0.y); o.y = pack2(bflo(u.y) * s0.z, bfhi(u.y) * s0.w);
    o.z = pack2(bflo(u.z) * s1.x, bfhi(u.z) * s1.y); o.w = pack2(bflo(u.w) * s1.z, bfhi(u.w) * s1.w);
    *(u32x4*)(mixed + T * 2048 + cb0 + c8) = o;
  }
}

__device__ __forceinline__ void attn_item(const Params& p, int item, unsigned char* smem) {
  bf16_t* Ks = (bf16_t*)smem;
  bf16_t* Vs = Ks + 64 * 136;
  bf16_t* Ps = Vs + 128 * 72;
  const int tid = threadIdx.x, lane = tid & 63, w = tid >> 6, fr = lane & 15, fq = lane >> 4;
  int seq, hq, qt;
  if (item < 1024) { seq = item >> 5; hq = (item >> 2) & 7; qt = item & 3; }
  else { const int i = item - 1024; seq = 32 + (i >> 8); hq = (i >> 5) & 7; qt = i & 31; }
  const bool sample = seq >= 32;
  const int sb = seq - 32;
  const int row0 = sample ? TP + sb * 2048 : seq * 256;
  const int kvh = hq >> 2;
  const int q0 = qt * 64;
  const bf16_t* proj = (const bf16_t*)(p.ws + OFF_C);
  const bf16_t* vT = (const bf16_t*)(p.ws + OFF_VT);
  const bf16_t* Kc = (const bf16_t*)(p.ws + OFF_KC);
  const bf16_t* VcT = (const bf16_t*)(p.ws + OFF_VCT);
  const float* cosT = (const float*)(p.ws + OFF_COS);
  const float* sinT = (const float*)(p.ws + OFF_SIN);
  bf16_t* mixed = (bf16_t*)(p.ws + OFF_PF);

  bf16x8 qa[4];
  {
    const int qrow = q0 + w * 16 + fr;
    const bf16_t* qp = proj + (size_t)(row0 + qrow) * 3584 + 2048 + hq * 128;
#pragma unroll
    for (int kk = 0; kk < 4; ++kk) qa[kk] = *(const bf16x8*)(qp + kk * 32 + fq * 8);
    if (sample) {
#pragma unroll
      for (int kk = 0; kk < 2; ++kk)
#pragma unroll
        for (int e = 0; e < 8; ++e) {
          const int i = kk * 32 + fq * 8 + e;
          const float c = cosT[qrow * 64 + i], s = sinT[qrow * 64 + i];
          const float x1 = bf2f((unsigned short)qa[kk][e]), x2 = bf2f((unsigned short)qa[kk + 2][e]);
          qa[kk][e] = (short)f2bf(x1 * c - x2 * s);
          qa[kk + 2][e] = (short)f2bf(x2 * c + x1 * s);
        }
    }
  }
  float m_[4], l_[4];
  f32x4 o[8];
#pragma unroll
  for (int j = 0; j < 4; ++j) { m_[j] = -1e30f; l_[j] = 0.f; }
#pragma unroll
  for (int n = 0; n < 8; ++n) o[n] = (f32x4){0.f, 0.f, 0.f, 0.f};
  int nl, ks0, nct;
  if (!sample) { nl = 4; ks0 = 0; nct = 0; }
  else {
    const int lo = q0 - 128 < 0 ? 0 : q0 - 128;
    const int hi = q0 + 192 > 2048 ? 2048 : q0 + 192;
    ks0 = lo; nl = (hi - lo) >> 6; nct = 8;
  }
  const int ntot = nl + nct;
  u32x4 kreg[4], vreg[4];
#define ATT_LOAD(k_) { const int kt_ = (k_) < nl ? 0 : 1; const int ks_ = kt_ == 0 ? ks0 + (k_) * 64 : ((k_) - nl) * 64; \
    _Pragma("unroll") for (int i = 0; i < 2; ++i) { const int idx = tid + 256 * i; const int r = idx >> 3, c8 = idx & 7; \
      const bf16_t* src = kt_ == 0 ? proj + (size_t)(row0 + ks_ + r) * 3584 + 3072 + kvh * 128 : Kc + ((size_t)((sb * 2 + kvh) * 512 + ks_ + r)) * 128; \
      kreg[2 * i] = *(const u32x4*)(src + c8 * 8); kreg[2 * i + 1] = *(const u32x4*)(src + 64 + c8 * 8); } \
    _Pragma("unroll") for (int i = 0; i < 4; ++i) { const int idx = tid + 256 * i; const int d = idx >> 3, c8 = idx & 7; \
      const bf16_t* src = kt_ == 0 ? vT + (size_t)(kvh * 128 + d) * TTOK + row0 + ks_ : VcT + ((size_t)((sb * 2 + kvh) * 128 + d)) * 512 + ks_; \
      vreg[i] = *(const u32x4*)(src + c8 * 8); } }
  ATT_LOAD(0);
  for (int k = 0; k < ntot; ++k) {
    const int ktype = k < nl ? 0 : 1;
    const int ks = ktype == 0 ? ks0 + k * 64 : (k - nl) * 64;
    __syncthreads();
#pragma unroll
    for (int i = 0; i < 2; ++i) {
      const int idx = tid + 256 * i;
      const int r = idx >> 3, c8 = idx & 7;
      u32x4 lo = kreg[2 * i], hi = kreg[2 * i + 1];
      if (sample && ktype == 0) {
        unsigned* lu = (unsigned*)&lo; unsigned* hu = (unsigned*)&hi;
        const float* cp = cosT + (ks + r) * 64 + c8 * 8; const float* sp = sinT + (ks + r) * 64 + c8 * 8;
#pragma unroll
        for (int e = 0; e < 4; ++e) {
          const float a1 = bflo(lu[e]), b1 = bfhi(lu[e]), a2 = bflo(hu[e]), b2 = bfhi(hu[e]);
          const float c0 = cp[2 * e], s0 = sp[2 * e], c1 = cp[2 * e + 1], s1 = sp[2 * e + 1];
          lu[e] = pack2(a1 * c0 - a2 * s0, b1 * c1 - b2 * s1);
          hu[e] = pack2(a2 * c0 + a1 * s0, b2 * c1 + b1 * s1);
        }
      }
      *(u32x4*)(Ks + r * 136 + c8 * 8) = lo;
      *(u32x4*)(Ks + r * 136 + 64 + c8 * 8) = hi;
    }
#pragma unroll
    for (int i = 0; i < 4; ++i) {
      const int idx = tid + 256 * i;
      const int d = idx >> 3, c8 = idx & 7;
      *(u32x4*)(Vs + d * 72 + c8 * 8) = vreg[i];
    }
    __syncthreads();
    if (k + 1 < ntot) ATT_LOAD(k + 1);
    f32x4 s[4];
#pragma unroll
    for (int n = 0; n < 4; ++n) s[n] = (f32x4){0.f, 0.f, 0.f, 0.f};
#pragma unroll
    for (int kk = 0; kk < 4; ++kk)
#pragma unroll
      for (int n = 0; n < 4; ++n) {
        const bf16x8 b = *(const bf16x8*)(Ks + (n * 16 + fr) * 136 + kk * 32 + fq * 8);
        s[n] = __builtin_amdgcn_mfma_f32_16x16x32_bf16(qa[kk], b, s[n], 0, 0, 0);
      }
    const bool domask = sample && ktype == 0;
#pragma unroll
    for (int j = 0; j < 4; ++j) {
      float mx = -1e30f;
#pragma unroll
      for (int n = 0; n < 4; ++n) {
        float v = s[n][j] * 0.08838834764831845f;
        if (domask) {
          const int dd = (q0 + w * 16 + fq * 4 + j) - (ks + n * 16 + fr);
          if (dd > 128 || dd < -128) v = -1e30f;
        }
        s[n][j] = v;
        mx = fmaxf(mx, v);
      }
      mx = row16_max(mx);
      const float mnew = fmaxf(m_[j], mx);
      const float alpha = __expf(m_[j] - mnew);
      m_[j] = mnew;
      l_[j] *= alpha;
#pragma unroll
      for (int nd = 0; nd < 8; ++nd) o[nd][j] *= alpha;
#pragma unroll
      for (int n = 0; n < 4; ++n) {
        const float pv = __expf(s[n][j] - mnew);
        l_[j] += pv;
        Ps[w * 1152 + (fq * 4 + j) * 72 + n * 16 + fr] = f2bf(pv);
      }
    }
    __syncthreads();
#pragma unroll
    for (int kk2 = 0; kk2 < 2; ++kk2) {
      const bf16x8 pa = *(const bf16x8*)(Ps + w * 1152 + fr * 72 + kk2 * 32 + fq * 8);
#pragma unroll
      for (int nd = 0; nd < 8; ++nd) {
        const bf16x8 vb = *(const bf16x8*)(Vs + (nd * 16 + fr) * 72 + kk2 * 32 + fq * 8);
        o[nd] = __builtin_amdgcn_mfma_f32_16x16x32_bf16(pa, vb, o[nd], 0, 0, 0);
      }
    }
  }
#undef ATT_LOAD
  const float sink = p.in[46][hq];
#pragma unroll
  for (int j = 0; j < 4; ++j) {
    float lt = l_[j];
    lt = row16_sum(lt);
    const float mf = fmaxf(m_[j], sink);
    const float sc = __expf(m_[j] - mf);
    const float den = lt * sc + __expf(sink - mf);
    const float inv = sc / den;
    const int T = row0 + q0 + w * 16 + fq * 4 + j;
#pragma unroll
    for (int nd = 0; nd < 8; ++nd) mixed[(size_t)T * 2048 + 1024 + hq * 128 + nd * 16 + fr] = f2bf(o[nd][j] * inv);
  }
}

__device__ __forceinline__ void mixer1a_phase(const Params& p, unsigned char* smem) {
  lnstat_rows(p);
  constexpr int NATT = 1536;
  for (int it = blockIdx.x; it < NATT; it += gridDim.x) {
    const int a = it < 512 ? 1024 + it : it - 512;
    for (int r_ = 0; r_ < (PROBE_ATT2 ? 2 : 1); ++r_) attn_item(p, a, smem);
  }
}
__device__ __forceinline__ void mixer1b_phase(const Params& p, unsigned char* smem) {
  constexpr int NGATE = 768;
  for (int it = blockIdx.x; it < NGATE; it += gridDim.x)
    for (int r_ = 0; r_ < (PROBE_GATE2 ? 2 : 1); ++r_) gate_item(p, it, smem);
}

__device__ __forceinline__ void wconv_late(const Params& p, unsigned char* smem) {
  constexpr int C0 = 16 * 88, C1 = 44 * 16, C2 = 16 * 56, C3 = 32 * 16, C4 = 16 * 88, C5 = 44 * 16;
  constexpr int TOT = C0 + C1 + C2 + C3 + C4 + C5;
  for (int it = blockIdx.x; it < TOT; it += gridDim.x) {
    int i = it;
    const float* src; int K, N; size_t off;
    if (i < C0) { src = p.in[14]; K = 1024; N = 5632; off = OFF_WUP0; }
    else if ((i -= C0) < C1) { src = p.in[17]; K = 2816; N = 1024; off = OFF_WDN0; }
    else if ((i -= C1) < C2) { src = p.in[40]; K = 1024; N = 3584; off = OFF_WIN1; }
    else if ((i -= C2) < C3) { src = p.in[41]; K = 2048; N = 1024; off = OFF_WOUT1; }
    else if ((i -= C3) < C4) { src = p.in[24]; K = 1024; N = 5632; off = OFF_WUP1; }
    else { i -= C4; src = p.in[27]; K = 2816; N = 1024; off = OFF_WDN1; }
    tconv_item(src, K, N, (bf16_t*)(p.ws + off), i, smem);
  }
}

__global__ __launch_bounds__(NT, 2) void mk_kernel(Params p) {
  extern __shared__ __attribute__((aligned(16))) unsigned char smem[];
  cg::grid_group grid = cg::this_grid();
  unsigned char* ws = p.ws;
#ifndef REPMASK
#define REPMASK 0
#endif
#define PH_REP(k) (((REPMASK >> (k)) & 1) ? 2 : 1)
  __shared__ uint4 xb_words;
  if (threadIdx.x == 0) xb_words = make_uint4(0u, 0u, 0u, 0u);
  __syncthreads();
  XcdBarrier xb = xcd_barrier_post((unsigned*)(p.ws + WS_NEED), (volatile LAS unsigned*)&xb_words);
  if (p.ph_lo < 0) grid.sync();
#define GSYNC() xcd_barrier(xb)
#define PHASE(k, ...) if (PH_ON(k) && p.ph_lo <= (k) && (k) < p.ph_hi) { for (int r_ = 0; r_ < PH_REP(k); ++r_) { if ((k) > p.ph_lo || r_ > 0) GSYNC(); __VA_ARGS__ } }
  PHASE(0, prep_phase(p, smem);)
  PHASE(1, norm0_phase(p);)
  PHASE(2, gemm_phase<8>((const bf16_t*)(ws + OFF_PF), 1024, (const bf16_t*)(ws + OFF_WIN0), 1024, 16, 57, 1024, smem,
                         EpiIn0{(bf16_t*)(ws + OFF_B), (float*)(ws + OFF_SMALL)}, 32, 0);)
  PHASE(3, if (blockIdx.x >= 128) {
             gemm_phase<8>((const bf16_t*)(ws + OFF_PF), 1024, (const bf16_t*)(ws + OFF_WIN0), 1024, 32, 57, 1024, smem,
                           EpiIn0{(bf16_t*)(ws + OFF_B), (float*)(ws + OFF_SMALL)}, 0, 128);
             sub_barrier((unsigned*)(p.ws + WS_NEED) + XCD_BAR_WORDS, gridDim.x - 128, (unsigned*)(p.ws + WS_NEED) + XB_TMO);
           }
           scan_phase(p, smem);)
  PHASE(4, combine0_phase(p);)
  PHASE(5, gemm_phase<6>((const bf16_t*)(ws + OFF_PF), 2048, (const bf16_t*)(ws + OFF_WOUT0), 2048, 64, 8, 2048, smem,
                         EpiOp{(bf16_t*)(ws + OFF_C)});
              wconv_late(p, smem);)
  PHASE(6, post_phase(p, 0, 0);)
  PHASE(7, gemm_phase<6>((const bf16_t*)(ws + OFF_PF), 1024, (const bf16_t*)(ws + OFF_WUP0), 1024, 64, 44, 1024, smem,
                         EpiUp{(bf16_t*)(ws + OFF_C)});)
  PHASE(8, convact_phase(p, 0);)
  PHASE(9, gemm_phase<6>((const bf16_t*)(ws + OFF_ACT), 2816, (const bf16_t*)(ws + OFF_WDN0), 2816, 64, 8, 2816, smem,
                         EpiOp{(bf16_t*)(ws + OFF_C)});)
  PHASE(10, post_phase(p, 0, 1);)
  PHASE(11, gemm_phase<8>((const bf16_t*)(ws + OFF_PF), 1024, (const bf16_t*)(ws + OFF_WIN1), 1024, 48, 28, 1024, smem,
                          EpiIn1{(bf16_t*)(ws + OFF_C), (bf16_t*)(ws + OFF_VT), p.out + OUT_K, p.out + OUT_V});)
  PHASE(12, mixer1a_phase(p, smem); GSYNC(); mixer1b_phase(p, smem);)
  PHASE(13, gemm_phase<6>((const bf16_t*)(ws + OFF_PF), 2048, (const bf16_t*)(ws + OFF_WOUT1), 2048, 64, 8, 2048, smem,
                          EpiOp{(bf16_t*)(ws + OFF_C)});)
  PHASE(14, post_phase(p, 1, 0);)
  PHASE(15, gemm_phase<6>((const bf16_t*)(ws + OFF_PF), 1024, (const bf16_t*)(ws + OFF_WUP1), 1024, 64, 44, 1024, smem,
                          EpiUp{(bf16_t*)(ws + OFF_C)});)
  PHASE(16, convact_phase(p, 1);)
  PHASE(17, gemm_phase<6>((const bf16_t*)(ws + OFF_ACT), 2816, (const bf16_t*)(ws + OFF_WDN1), 2816, 64, 8, 2816, smem,
                          EpiOp{(bf16_t*)(ws + OFF_C)});)
  PHASE(18, post_phase(p, 1, 1);)
#ifdef EXTRA_SYNCS
  if (p.ph_hi - p.ph_lo > 1) for (int e_ = 0; e_ < EXTRA_SYNCS; ++e_) GSYNC();
#endif
}

extern "C" void kernel_launch(void* const* d_in, const int* in_sizes, int n_in, void* d_out, int out_size, void* d_ws,
                              size_t ws_size, hipStream_t stream) {
  static int grid = 0;
  if (grid == 0) {
    int dev = 0, cus = 0, per_cu = 0;
    if (n_in != 47 || ws_size < WS_NEED + XCD_BAR_WORDS * 4 + 256) { fprintf(stderr, "kernel_launch: bad n_in %d or ws %zu\n", n_in, ws_size); grid = -1; return; }
    if (hipFuncSetAttribute((const void*)mk_kernel, hipFuncAttributeMaxDynamicSharedMemorySize, LDS_BYTES) != hipSuccess) { grid = -1; return; }
    hipGetDevice(&dev);
    hipDeviceGetAttribute(&cus, hipDeviceAttributeMultiprocessorCount, dev);
    if (hipOccupancyMaxActiveBlocksPerMultiprocessor(&per_cu, (const void*)mk_kernel, NT, LDS_BYTES) != hipSuccess || per_cu < 1) {
      fprintf(stderr, "kernel_launch: occupancy query failed (%d)\n", per_cu); grid = -1; return;
    }
    if (per_cu > 2) per_cu = 2;
    grid = cus * per_cu;
    if (grid < 256 || (grid & 7)) { fprintf(stderr, "kernel_launch: grid %d unsupported\n", grid); grid = -1; return; }
  }
  if (grid < 0) return;
  Params p{};
  for (int i = 0; i < 47; ++i) p.in[i] = (const float*)d_in[i];
  p.out = (float*)d_out;
  p.ws = (unsigned char*)d_ws;
  (void)hipMemsetAsync((char*)d_ws + WS_NEED, 0, XCD_BAR_WORDS * 4 + 256, stream);
#if SINGLE_LAUNCH
  p.ph_lo = 0; p.ph_hi = NPHASE;
  void* args[] = {&p};
  hipError_t e = hipLaunchCooperativeKernel((const void*)mk_kernel, dim3(grid), dim3(NT), args, LDS_BYTES, stream);
  if (e != hipSuccess) fprintf(stderr, "cooperative launch failed: %s (grid %d)\n", hipGetErrorString(e), grid);
#else
  for (int ph = 0; ph < NPHASE; ++ph) {
    p.ph_lo = ph; p.ph_hi = ph + 1;
    hipLaunchKernelGGL(mk_kernel, dim3(grid), dim3(NT), LDS_BYTES, stream, p);
  }
#endif
}
```

```cpp
#include <hip/hip_runtime.h>
#include <hip/hip_cooperative_groups.h>
#include <cstdio>
namespace cg = cooperative_groups;

typedef unsigned short bf16_t;
using bf16x8 = __attribute__((ext_vector_type(8))) short;
using f32x4 = __attribute__((ext_vector_type(4))) float;
using u32x4 = __attribute__((ext_vector_type(4))) unsigned;
using u32x2 = __attribute__((ext_vector_type(2))) unsigned;

#ifndef SINGLE_LAUNCH
#define SINGLE_LAUNCH 1
#endif

constexpr int NT = 256;
constexpr int TTOK = 12288;
constexpr int TP = 8192;
constexpr int LDS_BYTES = 73728;
constexpr int NPHASE = 19;
#ifndef PROBE_LONG2
#define PROBE_LONG2 0
#endif
#ifndef PROBE_ATT2
#define PROBE_ATT2 0
#endif
#ifndef PROBE_GATE2
#define PROBE_GATE2 0
#endif
#ifndef PH_ONLY
#define PH_ONLY -1
#endif
#ifndef PH_SKIP
#define PH_SKIP -1
#endif
#ifndef PH_SKIP2
#define PH_SKIP2 -1
#endif
#define PH_ON(x) ((PH_ONLY < 0 || PH_ONLY == (x)) && (x) != PH_SKIP && (x) != PH_SKIP2)

constexpr size_t OFF_MOD = 0;
constexpr size_t OFF_COS = 147456;
constexpr size_t OFF_SIN = OFF_COS + 524288;
constexpr size_t OFF_KC = OFF_SIN + 524288;
constexpr size_t OFF_VCT = OFF_KC + 524288;
constexpr size_t OFF_WSB = OFF_VCT + 524288;
constexpr size_t OFF_SMALL = OFF_WSB + 131072;
constexpr size_t OFF_A = 6291456;
constexpr size_t OFF_WIN0 = OFF_A;
constexpr size_t OFF_WOUT0 = OFF_WIN0 + 14942208;
constexpr size_t OFF_PF = OFF_WOUT0 + 4194304;
constexpr size_t OFF_ACT = OFF_A;
constexpr size_t OFF_B = 79691776;
constexpr size_t OFF_WUP0 = OFF_B;
constexpr size_t OFF_WDN0 = OFF_WUP0 + 11534336;
constexpr size_t OFF_WIN1 = OFF_WDN0 + 5767168;
constexpr size_t OFF_WOUT1 = OFF_WIN1 + 7340032;
constexpr size_t OFF_WUP1 = OFF_WOUT1 + 4194304;
constexpr size_t OFF_WDN1 = OFF_WUP1 + 11534336;
constexpr size_t OFF_C = OFF_WDN1 + 5767168;
constexpr size_t OFF_VT = OFF_C + 88080384;
constexpr size_t WS_NEED = OFF_C + 138412032;
static_assert(OFF_SMALL + 3145728 <= OFF_A, "small");
static_assert(OFF_PF + 50331648 <= OFF_B, "A region");
static_assert(OFF_ACT + 69206016 <= OFF_B, "act");
static_assert(OFF_B + 177733632 <= 268435456, "proj0");
static_assert(OFF_VT + 6291456 <= WS_NEED, "vt");
static_assert(WS_NEED <= 268435456, "ws");

constexpr size_t OUT_SSD = 12582912;
constexpr size_t OUT_DN = 20971520;
constexpr size_t OUT_K = 29360128;
constexpr size_t OUT_V = 31457280;

struct Params {
  const float* in[47];
  float* out;
  unsigned char* ws;
  int ph_lo, ph_hi;
};

typedef __bf16 bf16v2 __attribute__((ext_vector_type(2)));
typedef float f32v2 __attribute__((ext_vector_type(2)));
__device__ __forceinline__ unsigned short f2bf(float f) { const __bf16 b = (__bf16)f; return __builtin_bit_cast(unsigned short, b); }
__device__ __forceinline__ float bf2f(unsigned short h) { return __uint_as_float(((unsigned)h) << 16); }
__device__ __forceinline__ unsigned pack2(float a, float b) {
  const bf16v2 r = __builtin_convertvector((f32v2){a, b}, bf16v2);
  return __builtin_bit_cast(unsigned, r);
}
__device__ __forceinline__ float bflo(unsigned u) { return __uint_as_float(u << 16); }
__device__ __forceinline__ float bfhi(unsigned u) { return __uint_as_float(u & 0xffff0000u); }
template <int CTRL>
__device__ __forceinline__ float dppf(float v) { return __int_as_float(__builtin_amdgcn_update_dpp(0, __float_as_int(v), CTRL, 0xF, 0xF, true)); }
__device__ __forceinline__ float row16_sum(float v) { v += dppf<0xB1>(v); v += dppf<0x4E>(v); v += dppf<0x141>(v); v += dppf<0x140>(v); return v; }
__device__ __forceinline__ float row16_max(float v) { v = fmaxf(v, dppf<0xB1>(v)); v = fmaxf(v, dppf<0x4E>(v)); v = fmaxf(v, dppf<0x141>(v)); v = fmaxf(v, dppf<0x140>(v)); return v; }
__device__ __forceinline__ float wsum(float v) {
  v = row16_sum(v);
  v += __shfl_xor(v, 16);
  v += __shfl_xor(v, 32);
  return v;
}
__device__ __forceinline__ float siluf(float x) { return x * __builtin_amdgcn_rcpf(1.f + __expf(-x)); }
__device__ __forceinline__ float softplusf(float x) { return x > 20.f ? x : log1pf(expf(x)); }
__device__ __forceinline__ float geluf(float x) {
  const float u2 = 1.5957691216057308f * (x + 0.044715f * x * x * x);
  return x * __builtin_amdgcn_rcpf(1.f + __expf(-u2));
}

#define XB_TMO      128
#define XB_XCNT(j)  (256  + 64 * (j))
#define XB_XSUB(j)  (1280 + 64 * (j))
#define XB_XGEN(j)  (2304 + 64 * (j))
#define XB_TOP      3328
#define XB_TOPGEN   3392
#define XCD_BAR_WORDS 3456
#define XB_SPIN_CAP (1u << 18)
#define LAS __attribute__((address_space(3)))
__device__ __forceinline__ unsigned xb_ld(unsigned* p)              { return __hip_atomic_load(p, __ATOMIC_RELAXED, __HIP_MEMORY_SCOPE_AGENT); }
__device__ __forceinline__ unsigned xb_add(unsigned* p, unsigned v) { return __hip_atomic_fetch_add(p, v, __ATOMIC_RELAXED, __HIP_MEMORY_SCOPE_AGENT); }
__device__ __forceinline__ unsigned xb_xcc_id() { return (unsigned)__builtin_amdgcn_s_getreg((3 << 11) | 20) & 0xFu; }
#define XB_SPIN(cond, bar) do { unsigned _sp = 0; while (cond) { __builtin_amdgcn_s_sleep(1); \
    if ((++_sp & 255u) == 0u) { if (xb_ld(&(bar)[XB_TMO])) break; if (_sp > XB_SPIN_CAP) { atomicAdd(&(bar)[XB_TMO], 1u); break; } } } } while (0)
struct XcdBarrier { unsigned* bar; unsigned x; volatile LAS unsigned* st; };
__device__ __forceinline__ XcdBarrier xcd_barrier_post(unsigned* bar, volatile LAS unsigned* st) {
    XcdBarrier b; b.bar = bar; b.x = xb_xcc_id(); b.st = st;
    if (threadIdx.x == 0) (void)xb_add(&bar[XB_XCNT(b.x)], 1u);
    return b;
}
__device__ __forceinline__ void xcd_barrier_complete(unsigned* bar, unsigned x, unsigned& nloc, unsigned& nx) {
    const unsigned G = gridDim.x * gridDim.y * gridDim.z;
    unsigned sum, cnt, mine, sp = 0u;
    for (;;) {
        sum = 0u; cnt = 0u; mine = 0u;
#pragma unroll
        for (unsigned j = 0; j < 16; ++j) { const unsigned c = xb_ld(&bar[XB_XCNT(j)]); sum += c; cnt += (c > 0u) ? 1u : 0u; mine = (j == x) ? c : mine; }
        if (sum == G) break;
        __builtin_amdgcn_s_sleep(1);
        if ((++sp & 255u) == 0u) { if (xb_ld(&bar[XB_TMO])) break; if (sp > XB_SPIN_CAP) { atomicAdd(&bar[XB_TMO], 1u); break; } }
    }
    nloc = mine > 0u ? mine : 1u; nx = cnt > 0u ? cnt : 1u;
}
__device__ __forceinline__ void xcd_barrier(const XcdBarrier& b) {
    asm volatile("s_waitcnt vmcnt(0)" ::: "memory");
    __syncthreads();
    if (threadIdx.x == 0) {
        unsigned* bar = b.bar;
        __builtin_amdgcn_s_waitcnt(0);
        unsigned nloc = b.st[0], nx = b.st[1];
        if (nloc == 0u) { xcd_barrier_complete(bar, b.x, nloc, nx); b.st[0] = nloc; b.st[1] = nx; }
        const unsigned old = xb_add(&bar[XB_XSUB(b.x)], 1u);
        const unsigned gen = old / nloc;
        if (old + 1u == (gen + 1u) * nloc) {
            __builtin_amdgcn_fence(__ATOMIC_RELEASE, "agent");
            asm volatile("s_waitcnt vmcnt(0)" ::: "memory");
            const unsigned og = xb_add(&bar[XB_TOP], 1u);
            const unsigned tg = og / nx;
            if (og + 1u == (tg + 1u) * nx) xb_add(&bar[XB_TOPGEN], 1u);
            else XB_SPIN(xb_ld(&bar[XB_TOPGEN]) == tg, bar);
            __builtin_amdgcn_fence(__ATOMIC_ACQUIRE, "agent");
            xb_add(&bar[XB_XGEN(b.x)], 1u);
            asm volatile("s_waitcnt vmcnt(0)" ::: "memory");
        } else {
            XB_SPIN(xb_ld(&bar[XB_XGEN(b.x)]) == gen, bar);
            __builtin_amdgcn_fence(__ATOMIC_ACQUIRE, "agent");
            asm volatile("s_waitcnt vmcnt(0)" ::: "memory");
        }
    }
    __syncthreads();
}

__device__ __forceinline__ void sub_barrier(unsigned* cnt, unsigned target, unsigned* tmo) {
  asm volatile("s_waitcnt vmcnt(0)" ::: "memory");
  __syncthreads();
  if (threadIdx.x == 0) {
    __builtin_amdgcn_fence(__ATOMIC_RELEASE, "agent");
    asm volatile("s_waitcnt vmcnt(0)" ::: "memory");
    xb_add(cnt, 1u);
    unsigned sp = 0;
    while (xb_ld(cnt) < target) {
      __builtin_amdgcn_s_sleep(1);
      if ((++sp & 255u) == 0u) { if (xb_ld(tmo)) break; if (sp > XB_SPIN_CAP) { atomicAdd(tmo, 1u); break; } }
    }
    __builtin_amdgcn_fence(__ATOMIC_ACQUIRE, "agent");
    asm volatile("s_waitcnt vmcnt(0)" ::: "memory");
  }
  __syncthreads();
}

template <int MT, class Epi>
__device__ __forceinline__ void gemm_tile_big(const bf16_t* __restrict__ Ag, int lda, const bf16_t* __restrict__ Bg, int ldb,
                                              int K, int row_base, int col_base, unsigned char* smem, Epi& epi) {
  bf16_t* As = (bf16_t*)smem;
  bf16_t* Bs = As + (32 * MT) * 72;
  const int tid = threadIdx.x, lane = tid & 63, w = tid >> 6, wr = w >> 1, wc = w & 1, fr = lane & 15, fq = lane >> 4;
  f32x4 acc[MT][4];
#pragma unroll
  for (int m = 0; m < MT; ++m)
#pragma unroll
    for (int n = 0; n < 4; ++n) acc[m][n] = (f32x4){0.f, 0.f, 0.f, 0.f};
  u32x4 pa[MT], pb[4];
  const int lrow = tid >> 3, lkc = (tid & 7) * 8;
  const bf16_t* Ap = Ag + (size_t)lrow * lda + lkc;
  const bf16_t* Bp = Bg + (size_t)lrow * ldb + lkc;
#define G_LOAD(k0_) { _Pragma("unroll") for (int i = 0; i < MT; ++i) pa[i] = *(const u32x4*)(Ap + (size_t)(i * 32) * lda + (k0_)); \
                      _Pragma("unroll") for (int i = 0; i < 4; ++i) pb[i] = *(const u32x4*)(Bp + (size_t)(i * 32) * ldb + (k0_)); }
  G_LOAD(0);
  const int nk = K >> 6;
  for (int kt = 0; kt < nk; ++kt) {
    __syncthreads();
#pragma unroll
    for (int i = 0; i < MT; ++i) *(u32x4*)(As + (lrow + i * 32) * 72 + lkc) = pa[i];
#pragma unroll
    for (int i = 0; i < 4; ++i) *(u32x4*)(Bs + (lrow + i * 32) * 72 + lkc) = pb[i];
    __syncthreads();
    if (kt + 1 < nk) G_LOAD((kt + 1) << 6);
#pragma unroll
    for (int kk = 0; kk < 2; ++kk) {
      bf16x8 b[4];
#pragma unroll
      for (int n = 0; n < 4; ++n) b[n] = *(const bf16x8*)(Bs + (wc * 64 + n * 16 + fr) * 72 + kk * 32 + fq * 8);
#pragma unroll
      for (int m = 0; m < MT; ++m) {
        const bf16x8 a = *(const bf16x8*)(As + (wr * (16 * MT) + m * 16 + fr) * 72 + kk * 32 + fq * 8);
#pragma unroll
        for (int n = 0; n < 4; ++n) acc[m][n] = __builtin_amdgcn_mfma_f32_16x16x32_bf16(b[n], a, acc[m][n], 0, 0, 0);
      }
    }
  }
#undef G_LOAD
  __syncthreads();
  {
    bf16_t* Cw = (bf16_t*)smem + w * 9216;
    const bool dog = epi.gelu(col_base);
#pragma unroll
    for (int m = 0; m < MT; ++m)
#pragma unroll
      for (int n = 0; n < 4; ++n) {
        float v0 = acc[m][n][0], v1 = acc[m][n][1], v2 = acc[m][n][2], v3 = acc[m][n][3];
        epi.side(row_base + wr * (16 * MT) + m * 16 + fr, col_base + wc * 64 + n * 16 + fq * 4, v0, v1, v2, v3);
        if (dog) { v0 = geluf(v0); v1 = geluf(v1); v2 = geluf(v2); v3 = geluf(v3); }
        u32x2 o; o.x = pack2(v0, v1); o.y = pack2(v2, v3);
        *(u32x2*)(Cw + (m * 16 + fr) * 72 + n * 16 + fq * 4) = o;
      }
    asm volatile("s_waitcnt lgkmcnt(0)" ::: "memory");
#pragma unroll
    for (int i = 0; i < 2 * MT; ++i) {
      const int r = i * 8 + (lane >> 3), c8 = (lane & 7) * 8;
      const u32x4 v = *(const u32x4*)(Cw + r * 72 + c8);
      epi.store16(row_base + wr * (16 * MT) + r, col_base + wc * 64 + c8, v);
    }
  }
}

template <int MT, class Epi>
__device__ __forceinline__ void gemm_phase(const bf16_t* A, int lda, const bf16_t* Bt, int ldb, int nM, int nN, int K,
                                           unsigned char* smem, Epi epi, int tm_off = 0, int b_off = 0) {
  if ((int)blockIdx.x < b_off) return;
  if ((blockIdx.x >> 8) & 1) __builtin_amdgcn_s_sleep(15);
  const int nb = gridDim.x - b_off, b = blockIdx.x - b_off;
  int x, sl, nsl, nx;
  if ((nb & 7) == 0) { nx = 8; x = b & 7; sl = b >> 3; nsl = nb >> 3; } else { nx = 1; x = 0; sl = b; nsl = nb; }
#ifndef PMS
#define PMS 3
#endif
  constexpr int PM = 1 << PMS, PN = 64 >> PMS;
  const int nPn = (nN + PN - 1) / PN, nPm = (nM + PM - 1) / PM, npatch = nPn * nPm;
  for (int q = sl;; q += nsl) {
    const int pid = (q >> 6) * nx + x;
    if (pid >= npatch) break;
    const int slot = q & 63;
    const int tm = (pid / nPn) * PM + (slot & (PM - 1)), tn = (pid % nPn) * PN + (slot >> PMS);
    if (tm >= nM || tn >= nN) continue;
    gemm_tile_big<MT>(A + (size_t)((tm_off + tm) * 32 * MT) * lda, lda, Bt + (size_t)(tn * 128) * ldb, ldb, K, (tm_off + tm) * 32 * MT, tn * 128, smem, epi);
  }
}

struct EpiIn0 {
  bf16_t* proj; float* small;
  __device__ __forceinline__ bool gelu(int) const { return false; }
  __device__ __forceinline__ void side(int row, int col, float v0, float v1, float v2, float v3) const {
    if (col >= 3072 && col < 3104) *(float4*)(small + row * 64 + (col - 3072)) = make_float4(v0, v1, v2, v3);
    else if (col >= 7200 && col < 7232) *(float4*)(small + row * 64 + 32 + (col - 7200)) = make_float4(v0, v1, v2, v3);
  }
  __device__ __forceinline__ void store16(int row, int col, u32x4 v) const {
    if (col < 7232) *(u32x4*)(proj + (size_t)row * 7232 + col) = v;
  }
};
struct EpiOp {
  bf16_t* o;
  __device__ __forceinline__ bool gelu(int) const { return false; }
  __device__ __forceinline__ void side(int, int, float, float, float, float) const {}
  __device__ __forceinline__ void store16(int row, int col, u32x4 v) const { *(u32x4*)(o + (size_t)row * 1024 + col) = v; }
};
struct EpiUp {
  bf16_t* o;
  __device__ __forceinline__ bool gelu(int) const { return false; }
  __device__ __forceinline__ void side(int, int, float, float, float, float) const {}
  __device__ __forceinline__ void store16(int row, int col, u32x4 v) const { *(u32x4*)(o + (size_t)row * 5632 + col) = v; }
};
struct EpiIn1 {
  bf16_t* proj; bf16_t* vT; float* outk; float* outv;
  __device__ __forceinline__ bool gelu(int col_base) const { return col_base < 2048; }
  __device__ __forceinline__ void side(int row, int col, float v0, float v1, float v2, float v3) const {
    if (col >= 3072) {
      if (col < 3328) {
        if (row < TP) *(float4*)(outk + (size_t)row * 256 + (col - 3072)) = make_float4(v0, v1, v2, v3);
      } else {
        const int cv = col - 3328;
        vT[(size_t)(cv + 0) * TTOK + row] = f2bf(v0); vT[(size_t)(cv + 1) * TTOK + row] = f2bf(v1);
        vT[(size_t)(cv + 2) * TTOK + row] = f2bf(v2); vT[(size_t)(cv + 3) * TTOK + row] = f2bf(v3);
        if (row < TP) *(float4*)(outv + (size_t)row * 256 + cv) = make_float4(v0, v1, v2, v3);
      }
    }
  }
  __device__ __forceinline__ void store16(int row, int col, u32x4 v) const {
    if (col < 3328) *(u32x4*)(proj + (size_t)row * 3584 + col) = v;
  }
};

__device__ __forceinline__ void tconv_item(const float* __restrict__ src, int K, int N, bf16_t* __restrict__ dst, int item, unsigned char* smem) {
  float* t = (float*)smem;
  const int nkt = K >> 6;
  const int kt = item % nkt, nt = item / nkt;
  const int k0 = kt * 64, n0 = nt * 64;
  const int tid = threadIdx.x;
  __syncthreads();
  {
    const int c4 = (tid & 15) * 4;
#pragma unroll
    for (int i = 0; i < 4; ++i) {
      const int kk = (tid >> 4) + 16 * i;
      float4 v = make_float4(0.f, 0.f, 0.f, 0.f);
      if (n0 + c4 < N) v = *(const float4*)(src + (size_t)(k0 + kk) * N + n0 + c4);
      t[kk * 65 + c4 + 0] = v.x; t[kk * 65 + c4 + 1] = v.y; t[kk * 65 + c4 + 2] = v.z; t[kk * 65 + c4 + 3] = v.w;
    }
  }
  __syncthreads();
  {
    const int kc = (tid & 7) * 8;
#pragma unroll
    for (int i = 0; i < 2; ++i) {
      const int n = (tid >> 3) + 32 * i;
      u32x4 o;
      o.x = pack2(t[(kc + 0) * 65 + n], t[(kc + 1) * 65 + n]);
      o.y = pack2(t[(kc + 2) * 65 + n], t[(kc + 3) * 65 + n]);
      o.z = pack2(t[(kc + 4) * 65 + n], t[(kc + 5) * 65 + n]);
      o.w = pack2(t[(kc + 6) * 65 + n], t[(kc + 7) * 65 + n]);
      *(u32x4*)(dst + (size_t)(n0 + n) * K + k0 + kc) = o;
    }
  }
}

__device__ __forceinline__ void adaln_item(const Params& p, int item, unsigned char* smem) {
  float* sc = (float*)smem;
  float* red = sc + 3072;
  const int tid = threadIdx.x;
  const int layer = item / 192, cc = item % 192;
  const float* mw = p.in[layer == 0 ? 8 : 18];
  const float* mb = p.in[layer == 0 ? 9 : 19];
  __syncthreads();
  for (int i = tid; i < 3072; i += NT) {
    const int r = i >> 10, k = i & 1023;
    const float c = (r == 0) ? p.in[7][k] : p.in[6][(r - 1) * 1024 + k];
    sc[i] = siluf(c);
  }
  __syncthreads();
  const int cl = tid & 31, kg = tid >> 5;
  const float* wp = mw + cc * 32 + cl;
  float a0 = 0.f, a1 = 0.f, a2 = 0.f;
  for (int k0 = kg; k0 < 1024; k0 += 256) {
    float wv[32];
#pragma unroll
    for (int u = 0; u < 32; ++u) wv[u] = wp[(size_t)(k0 + 8 * u) * 6144];
#pragma unroll
    for (int u = 0; u < 32; ++u) {
      const int k = k0 + 8 * u;
      a0 += sc[k] * wv[u]; a1 += sc[1024 + k] * wv[u]; a2 += sc[2048 + k] * wv[u];
    }
  }
  red[(kg * 3 + 0) * 32 + cl] = a0; red[(kg * 3 + 1) * 32 + cl] = a1; red[(kg * 3 + 2) * 32 + cl] = a2;
  __syncthreads();
  if (tid < 96) {
    const int r = tid >> 5;
    float sacc = 0.f;
#pragma unroll
    for (int g = 0; g < 8; ++g) sacc += red[(g * 3 + r) * 32 + cl];
    float* mods = (float*)(p.ws + OFF_MOD);
    const int col = cc * 32 + cl;
    mods[(layer * 3 + r) * 6144 + col] = sacc + mb[col];
  }
}

__device__ __forceinline__ void prep_phase(const Params& p, unsigned char* smem) {
  const int tid = threadIdx.x;
  constexpr int I_ADA = 384, I_WIN0 = 16 * 114, I_WOUT0 = 32 * 16, I_WS = 64, I_ROPE = 128, I_KV = 256;
  constexpr int TOT = I_ADA + I_WIN0 + I_WOUT0 + I_WS + I_ROPE + I_KV;
  for (int it = blockIdx.x; it < TOT; it += gridDim.x) {
    int i = it;
    if (i < I_ADA) { adaln_item(p, i, smem); continue; }
    i -= I_ADA;
    if (i < I_WIN0 + I_WOUT0) {
      const bool first = i < I_WIN0;
      tconv_item(first ? p.in[28] : p.in[29], first ? 1024 : 2048, first ? 7232 : 1024,
                 (bf16_t*)(p.ws + (first ? OFF_WIN0 : OFF_WOUT0)), first ? i : i - I_WIN0, smem);
      continue;
    }
    i -= I_WIN0 + I_WOUT0;
    if (i < I_WS) {
      const int e = i * 1024 + tid * 4;
      const float4 v = *(const float4*)(p.in[44] + e);
      u32x2 o; o.x = pack2(v.x, v.y); o.y = pack2(v.z, v.w);
      *(u32x2*)((bf16_t*)(p.ws + OFF_WSB) + e) = o;
      continue;
    }
    i -= I_WS;
    if (i < I_ROPE) {
      float* ct = (float*)(p.ws + OFF_COS); float* st = (float*)(p.ws + OFF_SIN);
#pragma unroll
      for (int u = 0; u < 4; ++u) {
        const int e = i * 1024 + u * 256 + tid;
        const int t = e >> 6, j = e & 63;
        const float pos = (j < 32) ? (float)(t >> 6) : (float)(t & 63);
        const float inv = powf(10000.0f, -(float)(j & 31) / 32.0f);
        const float ang = pos * inv;
        ct[e] = cosf(ang); st[e] = sinf(ang);
      }
      continue;
    }
    i -= I_ROPE;
    {
      const int e = i * 1024 + tid * 4;
      const int d = e & 127, kh = (e >> 7) & 1, pos = (e >> 8) & 511, b = e >> 17;
      const float4 kv = *(const float4*)(p.in[4] + e);
      u32x2 o; o.x = pack2(kv.x, kv.y); o.y = pack2(kv.z, kv.w);
      *(u32x2*)((bf16_t*)(p.ws + OFF_KC) + ((size_t)((b * 2 + kh) * 512 + pos)) * 128 + d) = o;
      const float4 vv = *(const float4*)(p.in[5] + e);
      bf16_t* vd = (bf16_t*)(p.ws + OFF_VCT) + ((size_t)((b * 2 + kh) * 128 + d)) * 512 + pos;
      vd[0] = f2bf(vv.x); vd[512] = f2bf(vv.y); vd[1024] = f2bf(vv.z); vd[1536] = f2bf(vv.w);
    }
  }
}

__device__ __forceinline__ void modnorm_store(const float (&v)[16], float ss, const float* __restrict__ w, const float* __restrict__ shift,
                                              const float* __restrict__ scale, bf16_t* __restrict__ hrow, int lane) {
  const float rstd = rsqrtf(ss * (1.f / 1024.f) + 1e-6f);
#pragma unroll
  for (int i = 0; i < 4; ++i) {
    const int c = lane * 4 + 256 * i;
    const float4 ww = *(const float4*)(w + c), sh = *(const float4*)(shift + c), sc = *(const float4*)(scale + c);
    const float h0 = v[i * 4 + 0] * rstd * ww.x * (1.f + sc.x) + sh.x;
    const float h1 = v[i * 4 + 1] * rstd * ww.y * (1.f + sc.y) + sh.y;
    const float h2 = v[i * 4 + 2] * rstd * ww.z * (1.f + sc.z) + sh.z;
    const float h3 = v[i * 4 + 3] * rstd * ww.w * (1.f + sc.w) + sh.w;
    u32x2 o; o.x = pack2(h0, h1); o.y = pack2(h2, h3);
    *(u32x2*)(hrow + c) = o;
  }
}

__device__ __forceinline__ void norm0_phase(const Params& p) {
  const int lane = threadIdx.x & 63, w = threadIdx.x >> 6;
  const float* mods = (const float*)(p.ws + OFF_MOD);
  bf16_t* hbuf = (bf16_t*)(p.ws + OFF_PF);
  for (int row = blockIdx.x * 4 + w; row < TTOK; row += gridDim.x * 4) {
    const float* xr = row < TP ? p.in[0] + (size_t)row * 1024 : p.in[1] + (size_t)(row - TP) * 1024;
    const int mr = row < TP ? 0 : 1 + ((row - TP) >> 11);
    const float* mod = mods + (0 * 3 + mr) * 6144;
    float v[16]; float ss = 0.f;
#pragma unroll
    for (int i = 0; i < 4; ++i) {
      const float4 t = *(const float4*)(xr + lane * 4 + 256 * i);
      v[i * 4] = t.x; v[i * 4 + 1] = t.y; v[i * 4 + 2] = t.z; v[i * 4 + 3] = t.w;
      ss += t.x * t.x + t.y * t.y + t.z * t.z + t.w * t.w;
    }
    ss = wsum(ss);
    modnorm_store(v, ss, p.in[10], mod, mod + 1024, hbuf + (size_t)row * 1024, lane);
  }
}

__device__ __forceinline__ void post_phase(const Params& p, int layer, int which) {
  const int lane = threadIdx.x & 63, w = threadIdx.x >> 6;
  const float* mods = (const float*)(p.ws + OFF_MOD);
  const bf16_t* op = (const bf16_t*)(p.ws + OFF_C);
  bf16_t* hbuf = (bf16_t*)(p.ws + OFF_PF);
  const int lb = layer == 0 ? 8 : 18;
  const float* wpost = p.in[lb + (which == 0 ? 3 : 5)];
  const bool has_next = !(layer == 1 && which == 1);
  const float* wnext = which == 0 ? p.in[lb + 4] : p.in[20];
  const int nlayer = which == 0 ? layer : 1;
  const int sidx = which == 0 ? 3 : 0;
  for (int row = blockIdx.x * 4 + w; row < TTOK; row += gridDim.x * 4) {
    const int mr = row < TP ? 0 : 1 + ((row - TP) >> 11);
    const float* mod = mods + (layer * 3 + mr) * 6144;
    const float* gate = mod + (which == 0 ? 2 : 5) * 1024;
    const float* xold;
    if (layer == 0 && which == 0) xold = row < TP ? p.in[0] + (size_t)row * 1024 : p.in[1] + (size_t)(row - TP) * 1024;
    else xold = p.out + (size_t)row * 1024;
    const bf16_t* orow = op + (size_t)row * 1024;
    float v[16]; float ss = 0.f;
#pragma unroll
    for (int i = 0; i < 4; ++i) {
      const u32x2 tt = *(const u32x2*)(orow + lane * 4 + 256 * i);
      const float4 t = make_float4(bflo(tt.x), bfhi(tt.x), bflo(tt.y), bfhi(tt.y));
      v[i * 4] = t.x; v[i * 4 + 1] = t.y; v[i * 4 + 2] = t.z; v[i * 4 + 3] = t.w;
      ss += t.x * t.x + t.y * t.y + t.z * t.z + t.w * t.w;
    }
    ss = wsum(ss);
    const float rstd = rsqrtf(ss * (1.f / 1024.f) + 1e-6f);
    float ss2 = 0.f;
#pragma unroll
    for (int i = 0; i < 4; ++i) {
      const int c = lane * 4 + 256 * i;
      const float4 xo = *(const float4*)(xold + c), ww = *(const float4*)(wpost + c), gg = *(const float4*)(gate + c);
      float4 xn;
      xn.x = xo.x + gg.x * (v[i * 4 + 0] * rstd * ww.x);
      xn.y = xo.y + gg.y * (v[i * 4 + 1] * rstd * ww.y);
      xn.z = xo.z + gg.z * (v[i * 4 + 2] * rstd * ww.z);
      xn.w = xo.w + gg.w * (v[i * 4 + 3] * rstd * ww.w);
      *(float4*)(p.out + (size_t)row * 1024 + c) = xn;
      v[i * 4] = xn.x; v[i * 4 + 1] = xn.y; v[i * 4 + 2] = xn.z; v[i * 4 + 3] = xn.w;
      ss2 += xn.x * xn.x + xn.y * xn.y + xn.z * xn.z + xn.w * xn.w;
    }
    if (has_next) {
      ss2 = wsum(ss2);
      const float* nmod = mods + (nlayer * 3 + mr) * 6144;
      modnorm_store(v, ss2, wnext, nmod + sidx * 1024, nmod + (sidx + 1) * 1024, hbuf + (size_t)row * 1024, lane);
    }
  }
}

__device__ __forceinline__ float wave_incl_scan(float v, int lane) {
  v += dppf<0x111>(v); v += dppf<0x112>(v); v += dppf<0x114>(v); v += dppf<0x118>(v);
  const float r0 = __int_as_float(__builtin_amdgcn_readlane(__float_as_int(v), 15));
  if (lane >= 16) v += r0;
  return v;
}

template <int NOUT, int NCH, class F>
__device__ __forceinline__ void conv_chan(const bf16_t* rc, float w0, float w1, float w2, float w3, float w4, float bias, F f) {
  float r0 = bf2f(rc[0]), r1 = bf2f(rc[NCH]), r2 = bf2f(rc[2 * NCH]), r3 = bf2f(rc[3 * NCH]);
#pragma unroll
  for (int i = 0; i < NOUT; ++i) {
    const float r4 = bf2f(rc[(i + 4) * NCH]);
    const float v = bias + r0 * w0 + r1 * w1 + r2 * w2 + r3 * w3 + r4 * w4;
    f(i, siluf(v));
    r0 = r1; r1 = r2; r2 = r3; r3 = r4;
  }
}

__device__ __forceinline__ void ssd_item(const Params& p, int seq, int dir, int h, unsigned char* smem) {
  const int tid = threadIdx.x, lane = tid & 63, w = tid >> 6, fr = lane & 15, fq = lane >> 4;
  const int rt = w & 1, ch = w >> 1;
  bf16_t* Ct = (bf16_t*)smem;
  bf16_t* Bt = (bf16_t*)(smem + 8704);
  bf16_t* BdT = (bf16_t*)(smem + 17408);
  bf16_t* XT = (bf16_t*)(smem + 27648);
  bf16_t* SCR = (bf16_t*)(smem + 32768);
  bf16_t* PT = (bf16_t*)(smem + 35328);
  float* sc = (float*)(smem + 52736);
  bf16_t* RAW = (bf16_t*)smem;
  const int L = seq < 32 ? 256 : 2048;
  const int row0 = seq < 32 ? seq * 256 : TP + (seq - 32) * 2048;
  const bf16_t* proj = (const bf16_t*)(p.ws + OFF_B);
  const float* small = (const float*)(p.ws + OFF_SMALL);
  bf16_t* Pout = dir == 0 ? (bf16_t*)(p.ws + OFF_PF) : (bf16_t*)p.out;
  const int g = h >> 2;
  const float Aneg = -expf(p.in[33][dir * 16 + h]);
  const float dtb = p.in[32][dir * 16 + h];
  const float Dh = p.in[34][h];
  const int step = dir == 0 ? 1 : -1;
  const int qd = tid >> 6;
  int wcA, wcB;
  if (tid < 64) wcA = h * 64 + tid;
  else if (tid < 192) wcA = 1024 + g * 128 + (tid - 64);
  else wcA = 1536 + g * 128 + (tid - 192);
  wcB = 1536 + g * 128 + 64 + (tid & 63);
  float wa0, wa1, wa2, wa3, wa4, ba, wb0, wb1, wb2, wb3, wb4, bb;
  {
    const float* cw = p.in[30];
    const float t0 = cw[0 * 2048 + wcA], t1 = cw[1 * 2048 + wcA], t2 = cw[2 * 2048 + wcA], t3 = cw[3 * 2048 + wcA], t4 = cw[4 * 2048 + wcA];
    wa0 = dir ? t4 : t0; wa1 = dir ? t3 : t1; wa2 = t2; wa3 = dir ? t1 : t3; wa4 = dir ? t0 : t4;
    ba = p.in[31][wcA];
    const float u0 = cw[0 * 2048 + wcB], u1 = cw[1 * 2048 + wcB], u2 = cw[2 * 2048 + wcB], u3 = cw[3 * 2048 + wcB], u4 = cw[4 * 2048 + wcB];
    wb0 = dir ? u4 : u0; wb1 = dir ? u3 : u1; wb2 = u2; wb3 = dir ? u1 : u3; wb4 = dir ? u0 : u4;
    bb = p.in[31][wcB];
  }
  f32x4 accS[8];
  if (seq < 32) {
#pragma unroll
    for (int nt = 0; nt < 8; ++nt) accS[nt] = (f32x4){0.f, 0.f, 0.f, 0.f};
  } else {
    const float* s0 = p.in[2] + ((size_t)(((seq - 32) * 2 + dir) * 16 + h)) * 8192;
#pragma unroll
    for (int nt = 0; nt < 8; ++nt)
#pragma unroll
      for (int jj = 0; jj < 4; ++jj) accS[nt][jj] = s0[(16 * w + fq * 4 + jj) * 128 + nt * 16 + fr];
  }
#define SSD_PREFETCH(ci_) { const int tp_ = dir == 0 ? (ci_) * 32 : L - 1 - (ci_) * 32; \
    _Pragma("unroll") for (int u = 0; u < 6; ++u) pre[u] = (u32x4){0u, 0u, 0u, 0u}; \
    { const int t_ = tp_ + step * ((tid >> 3) - 2); \
      if (t_ >= 0 && t_ < L) { const bf16_t* rb_ = proj + (size_t)(row0 + t_) * 7232 + (tid & 7) * 8; \
        pre[0] = *(const u32x4*)(rb_ + 1024 + h * 64); pre[1] = *(const u32x4*)(rb_ + 2048 + g * 128); pre[2] = *(const u32x4*)(rb_ + 2048 + g * 128 + 64); \
        pre[3] = *(const u32x4*)(rb_ + 2560 + g * 128); pre[4] = *(const u32x4*)(rb_ + 2560 + g * 128 + 64); } } \
    { const int t_ = tp_ + step * (30 + (tid >> 6)); const int ln_ = tid & 63; \
      if (ln_ < 40 && t_ >= 0 && t_ < L) { \
        const int col_ = ln_ < 8 ? (1024 + h * 64 + ln_ * 8) : (ln_ < 24 ? (2048 + g * 128 + (ln_ - 8) * 8) : (2560 + g * 128 + (ln_ - 24) * 8)); \
        pre[5] = *(const u32x4*)(proj + (size_t)(row0 + t_) * 7232 + col_); } } }
  const int nch = L >> 5;
  u32x4 pre[6];
  SSD_PREFETCH(0);
  float psc0 = 0.f;
#define SSD_PREFSC(ci_) { if (tid < 32) { const int tp_ = dir == 0 ? (ci_) * 32 : L - 1 - (ci_) * 32; psc0 = small[(size_t)(row0 + tp_ + step * tid) * 64 + dir * 16 + h]; } }
  SSD_PREFSC(0);
  if (L > 256) __builtin_amdgcn_s_setprio(3);
  for (int ci = 0; ci < nch; ++ci) {
    const int tpos0 = dir == 0 ? ci * 32 : L - 1 - ci * 32;
    int tl_ = threadIdx.x;
    asm volatile("" : "+v"(tl_));
    const int tid = tl_, lane = tid & 63, w = tid >> 6, fr = lane & 15, fq = lane >> 4, rt = w & 1, ch = w >> 1, qd = tid >> 6;
    __syncthreads();
#pragma unroll
    for (int nt = 0; nt < 8; ++nt)
#pragma unroll
      for (int jj = 0; jj < 4; ++jj) PT[(16 * w + fq * 4 + jj) * 136 + nt * 16 + fr] = f2bf(accS[nt][jj]);
    if (w == 0) {
      float av = 0.f, dtv = 0.f;
      if (lane < 32) {
        dtv = softplusf(psc0 + dtb);
        av = dtv * Aneg;
      }
      const float cum = wave_incl_scan(av, lane);
      const float cl = __int_as_float(__builtin_amdgcn_readlane(__float_as_int(cum), 31));
      if (lane < 32) { sc[lane] = dtv; sc[32 + lane] = cum; sc[64 + lane] = __expf(cum); sc[96 + lane] = __expf(cl - cum); }
      if (lane == 31) sc[128] = __expf(cum);
    }
    {
      const int r5 = tid >> 3, c5 = (tid & 7) * 8;
#pragma unroll
      for (int u = 0; u < 5; ++u) *(u32x4*)(RAW + r5 * 320 + u * 64 + c5) = pre[u];
      const int ln = tid & 63;
      if (ln < 40) *(u32x4*)(RAW + (32 + (tid >> 6)) * 320 + ln * 8) = pre[5];
    }
    __syncthreads();
    float o1[32], o2[8];
    conv_chan<32, 320>(RAW + tid, wa0, wa1, wa2, wa3, wa4, ba, [&](int i, float v) { o1[i] = v; });
    conv_chan<8, 320>(RAW + qd * 8 * 320 + 256 + (tid & 63), wb0, wb1, wb2, wb3, wb4, bb, [&](int i, float v) { o2[i] = v; });
    bf16x8 hb[2][4];
#pragma unroll
    for (int t = 0; t < 2; ++t)
#pragma unroll
      for (int kk = 0; kk < 4; ++kk) hb[t][kk] = *(const bf16x8*)(PT + ((2 * ch + t) * 16 + fr) * 136 + kk * 32 + fq * 8);
    __syncthreads();
    if (tid < 64) {
#pragma unroll
      for (int i8 = 0; i8 < 4; ++i8) {
        u32x4 o_;
        o_.x = pack2(o1[i8 * 8 + 0] * sc[i8 * 8 + 0], o1[i8 * 8 + 1] * sc[i8 * 8 + 1]);
        o_.y = pack2(o1[i8 * 8 + 2] * sc[i8 * 8 + 2], o1[i8 * 8 + 3] * sc[i8 * 8 + 3]);
        o_.z = pack2(o1[i8 * 8 + 4] * sc[i8 * 8 + 4], o1[i8 * 8 + 5] * sc[i8 * 8 + 5]);
        o_.w = pack2(o1[i8 * 8 + 6] * sc[i8 * 8 + 6], o1[i8 * 8 + 7] * sc[i8 * 8 + 7]);
        *(u32x4*)(XT + tid * 40 + i8 * 8) = o_;
      }
    } else if (tid < 192) {
      const int n = tid - 64;
#pragma unroll
      for (int i = 0; i < 32; ++i) Bt[i * 136 + n] = f2bf(o1[i]);
#pragma unroll
      for (int i8 = 0; i8 < 4; ++i8) {
        u32x4 o_;
        o_.x = pack2(o1[i8 * 8 + 0] * sc[96 + i8 * 8 + 0], o1[i8 * 8 + 1] * sc[96 + i8 * 8 + 1]);
        o_.y = pack2(o1[i8 * 8 + 2] * sc[96 + i8 * 8 + 2], o1[i8 * 8 + 3] * sc[96 + i8 * 8 + 3]);
        o_.z = pack2(o1[i8 * 8 + 4] * sc[96 + i8 * 8 + 4], o1[i8 * 8 + 5] * sc[96 + i8 * 8 + 5]);
        o_.w = pack2(o1[i8 * 8 + 6] * sc[96 + i8 * 8 + 6], o1[i8 * 8 + 7] * sc[96 + i8 * 8 + 7]);
        *(u32x4*)(BdT + n * 40 + i8 * 8) = o_;
      }
    } else {
      const int n = tid - 192;
#pragma unroll
      for (int i = 0; i < 32; ++i) Ct[i * 136 + n] = f2bf(o1[i]);
    }
#pragma unroll
    for (int e = 0; e < 8; ++e) Ct[(qd * 8 + e) * 136 + 64 + (tid & 63)] = f2bf(o2[e]);
    __syncthreads();
    if (ci + 1 < nch) { SSD_PREFETCH(ci + 1); SSD_PREFSC(ci + 1); }
    f32x4 G = (f32x4){0.f, 0.f, 0.f, 0.f};
    f32x4 Y[2];
    Y[0] = (f32x4){0.f, 0.f, 0.f, 0.f}; Y[1] = (f32x4){0.f, 0.f, 0.f, 0.f};
#pragma unroll
    for (int kk = 0; kk < 4; ++kk) {
      const bf16x8 ca = *(const bf16x8*)(Ct + (16 * rt + fr) * 136 + kk * 32 + fq * 8);
      const bf16x8 bbv = *(const bf16x8*)(Bt + (16 * ch + fr) * 136 + kk * 32 + fq * 8);
      G = __builtin_amdgcn_mfma_f32_16x16x32_bf16(ca, bbv, G, 0, 0, 0);
      Y[0] = __builtin_amdgcn_mfma_f32_16x16x32_bf16(ca, hb[0][kk], Y[0], 0, 0, 0);
      Y[1] = __builtin_amdgcn_mfma_f32_16x16x32_bf16(ca, hb[1][kk], Y[1], 0, 0, 0);
    }
#pragma unroll
    for (int jj = 0; jj < 4; ++jj) {
      const int i = 16 * rt + fq * 4 + jj;
      const int j = 16 * ch + fr;
      float sv = (j <= i) ? G[jj] * __expf(sc[32 + i] - sc[32 + j]) : 0.f;
      if (dir == 0 && j == i) sv += Dh * __builtin_amdgcn_rcpf(fmaxf(sc[i], 1e-30f));
      SCR[i * 40 + j] = f2bf(sv);
      const float ec = sc[64 + i];
      Y[0][jj] *= ec; Y[1][jj] *= ec;
    }
    __syncthreads();
    {
      const bf16x8 sa = *(const bf16x8*)(SCR + (16 * rt + fr) * 40 + fq * 8);
#pragma unroll
      for (int t = 0; t < 2; ++t) {
        const bf16x8 xb = *(const bf16x8*)(XT + ((2 * ch + t) * 16 + fr) * 40 + fq * 8);
        Y[t] = __builtin_amdgcn_mfma_f32_16x16x32_bf16(sa, xb, Y[t], 0, 0, 0);
      }
    }
#pragma unroll
    for (int jj = 0; jj < 4; ++jj) {
      const int i = 16 * rt + fq * 4 + jj;
      const int t = tpos0 + step * i;
#pragma unroll
      for (int u = 0; u < 2; ++u) Pout[(size_t)(row0 + t) * 2048 + h * 64 + (2 * ch + u) * 16 + fr] = f2bf(Y[u][jj]);
    }
    {
      const float el = sc[128];
      const bf16x8 xa = *(const bf16x8*)(XT + (16 * w + fr) * 40 + fq * 8);
#pragma unroll
      for (int nt = 0; nt < 8; ++nt) {
        accS[nt] *= el;
        const bf16x8 bd = *(const bf16x8*)(BdT + (nt * 16 + fr) * 40 + fq * 8);
        accS[nt] = __builtin_amdgcn_mfma_f32_16x16x32_bf16(xa, bd, accS[nt], 0, 0, 0);
      }
    }
  }
  __builtin_amdgcn_s_setprio(0);
#undef SSD_PREFETCH
#undef SSD_PREFSC
  if (seq < 32) {
    float* so = p.out + OUT_SSD + ((size_t)((seq * 2 + dir) * 16 + h)) * 8192;
#pragma unroll
    for (int nt = 0; nt < 8; ++nt)
#pragma unroll
      for (int jj = 0; jj < 4; ++jj) so[(16 * w + fq * 4 + jj) * 128 + nt * 16 + fr] = accS[nt][jj];
  }
}

__device__ __forceinline__ void dn_item(const Params& p, int seq, int dir, int h, int half, unsigned char* smem) {
  const int tid = threadIdx.x, lane = tid & 63, w = tid >> 6, fr = lane & 15, fq = lane >> 4;
  const int rt = w & 1, ch = w >> 1;
  bf16_t* RQ = (bf16_t*)smem;
  bf16_t* RK = (bf16_t*)(smem + 8704);
  bf16_t* RS = (bf16_t*)(smem + 17408);
  bf16_t* RE = (bf16_t*)(smem + 34816);
  unsigned char* RAb = smem + 45056;
  bf16_t* RW = (bf16_t*)(smem + 49664);
  float* RU = (float*)(smem + 58368);
  bf16_t* RV = (bf16_t*)(smem + 66688);
  float* sc = (float*)(smem + 71808);
  bf16_t* RAWKV = RW;
  bf16_t* RAWQ = RE;
  const int L = seq < 32 ? 256 : 2048;
  const int row0 = seq < 32 ? seq * 256 : TP + (seq - 32) * 2048;
  const bf16_t* proj = (const bf16_t*)(p.ws + OFF_B);
  const float* small = (const float*)(p.ws + OFF_SMALL);
  bf16_t* Pout = dir == 0 ? (bf16_t*)(p.ws + OFF_PF) : (bf16_t*)p.out;
  const float Aneg = -expf(p.in[38][dir * 8 + h]);
  const float dtb = p.in[37][dir * 8 + h];
  const int step = dir == 0 ? 1 : -1;
  const bool isk = tid < 128, isv = tid >= 128 && tid < 192;
  const int wc1 = isk ? (1024 + h * 128 + tid) : (2048 + h * 128 + half * 64 + ((tid - 128) & 63));
  const int wc2 = h * 128 + (tid & 127);
  float wa0, wa1, wa2, wa3, wa4, wb0, wb1, wb2, wb3, wb4;
  {
    const float* cw = p.in[36];
    const float t0 = cw[0 * 3072 + wc1], t1 = cw[1 * 3072 + wc1], t2 = cw[2 * 3072 + wc1], t3 = cw[3 * 3072 + wc1], t4 = cw[4 * 3072 + wc1];
    wa0 = dir ? t4 : t0; wa1 = dir ? t3 : t1; wa2 = t2; wa3 = dir ? t1 : t3; wa4 = dir ? t0 : t4;
    const float u0 = cw[0 * 3072 + wc2], u1 = cw[1 * 3072 + wc2], u2 = cw[2 * 3072 + wc2], u3 = cw[3 * 3072 + wc2], u4 = cw[4 * 3072 + wc2];
    wb0 = dir ? u4 : u0; wb1 = dir ? u3 : u1; wb2 = u2; wb3 = dir ? u1 : u3; wb4 = dir ? u0 : u4;
  }
  const int qhalf = tid >> 7;
  f32x4 accS[2][4];
  if (seq < 32) {
#pragma unroll
    for (int m = 0; m < 2; ++m)
#pragma unroll
      for (int n = 0; n < 4; ++n) accS[m][n] = (f32x4){0.f, 0.f, 0.f, 0.f};
  } else {
    const float* s0 = p.in[3] + ((size_t)(((seq - 32) * 2 + dir) * 8 + h)) * 16384 + half * 64;
#pragma unroll
    for (int m = 0; m < 2; ++m)
#pragma unroll
      for (int n = 0; n < 4; ++n)
#pragma unroll
        for (int jj = 0; jj < 4; ++jj) accS[m][n][jj] = s0[(32 * w + m * 16 + fq * 4 + jj) * 128 + n * 16 + fr];
  }
#define DN_PREFETCH(ci_) { const int tp_ = dir == 0 ? (ci_) * 32 : L - 1 - (ci_) * 32; \
    _Pragma("unroll") for (int u = 0; u < 6; ++u) pre[u] = (u32x4){0u, 0u, 0u, 0u}; \
    { const int t_ = tp_ + step * ((tid >> 3) - 2); \
      if (t_ >= 0 && t_ < L) { const bf16_t* rb_ = proj + (size_t)(row0 + t_) * 7232 + 3104 + h * 128 + (tid & 7) * 8; \
        pre[0] = *(const u32x4*)(rb_ + 1024); pre[1] = *(const u32x4*)(rb_ + 1024 + 64); pre[2] = *(const u32x4*)(rb_ + 2048 + half * 64); \
        pre[3] = *(const u32x4*)(rb_); pre[4] = *(const u32x4*)(rb_ + 64); } } \
    { const int t_ = tp_ + step * (30 + (tid >> 6)); const int ln_ = tid & 63; \
      if (ln_ < 40 && t_ >= 0 && t_ < L) { \
        const int col_ = 3104 + h * 128 + (ln_ < 16 ? (1024 + ln_ * 8) : (ln_ < 24 ? (2048 + half * 64 + (ln_ - 16) * 8) : ((ln_ - 24) * 8))); \
        pre[5] = *(const u32x4*)(proj + (size_t)(row0 + t_) * 7232 + col_); } } }
  const int nch = L >> 5;
  u32x4 pre[6];
  DN_PREFETCH(0);
  float psc0 = 0.f, psc1 = 0.f;
#define DN_PREFSC(ci_) { if (tid < 32) { const int tp_ = dir == 0 ? (ci_) * 32 : L - 1 - (ci_) * 32; const float* sm_ = small + (size_t)(row0 + tp_ + step * tid) * 64; \
    psc0 = sm_[32 + dir * 8 + h]; psc1 = sm_[48 + dir * 8 + h]; } }
  DN_PREFSC(0);
  if (L > 256) __builtin_amdgcn_s_setprio(3);
  for (int ci = 0; ci < nch; ++ci) {
    const int tpos0 = dir == 0 ? ci * 32 : L - 1 - ci * 32;
    int tl_ = threadIdx.x;
    asm volatile("" : "+v"(tl_));
    const int tid = tl_, lane = tid & 63, w = tid >> 6, fr = lane & 15, fq = lane >> 4, rt = w & 1, ch = w >> 1, qhalf = tid >> 7;
    const bool isk = tid < 128, isv = tid >= 128 && tid < 192;
    __syncthreads();
#pragma unroll
    for (int m = 0; m < 2; ++m)
#pragma unroll
      for (int n = 0; n < 4; ++n)
        { u32x2 o_; o_.x = pack2(accS[m][n][0], accS[m][n][1]); o_.y = pack2(accS[m][n][2], accS[m][n][3]);
          *(u32x2*)(RS + (n * 16 + fr) * 136 + 32 * w + m * 16 + fq * 4) = o_; }
    if (w == 0) {
      float gi = 0.f, be = 0.f;
      if (lane < 32) {
        gi = Aneg * softplusf(psc0 + dtb);
        be = __builtin_amdgcn_rcpf(1.f + __expf(-psc1));
      }
      const float gcs = wave_incl_scan(gi, lane);
      const float gl = __int_as_float(__builtin_amdgcn_readlane(__float_as_int(gcs), 31));
      if (lane < 32) { sc[lane] = gcs; sc[32 + lane] = __expf(gcs); sc[64 + lane] = be; sc[160 + lane] = __expf(gl - gcs); }
      if (lane == 31) sc[224] = __expf(gcs);
    }
    {
      const int r5 = tid >> 3, c5 = (tid & 7) * 8;
      *(u32x4*)(RAWKV + r5 * 192 + c5) = pre[0];
      *(u32x4*)(RAWKV + r5 * 192 + 64 + c5) = pre[1];
      *(u32x4*)(RAWKV + r5 * 192 + 128 + c5) = pre[2];
      *(u32x4*)(RAWQ + r5 * 128 + c5) = pre[3];
      *(u32x4*)(RAWQ + r5 * 128 + 64 + c5) = pre[4];
      const int r6 = 32 + (tid >> 6), ln = tid & 63;
      if (ln < 24) *(u32x4*)(RAWKV + r6 * 192 + ln * 8) = pre[5];
      else if (ln < 40) *(u32x4*)(RAWQ + r6 * 128 + (ln - 24) * 8) = pre[5];
    }
    __syncthreads();
    f32v2 kvp[16];
#define KV(i_) kvp[(i_) >> 1][(i_) & 1]
    if (tid < 192) conv_chan<32, 192>(RAWKV + tid, wa0, wa1, wa2, wa3, wa4, 0.f, [&](int i, float v) { KV(i) = v; });
    if (isk) {
#pragma unroll
      for (int i = 0; i < 32; ++i) RK[i * 136 + tid] = f2bf(KV(i));
    }
    conv_chan<16, 128>(RAWQ + qhalf * 16 * 128 + (tid & 127), wb0, wb1, wb2, wb3, wb4, 0.f,
                       [&](int i, float v) { RQ[(qhalf * 16 + i) * 136 + (tid & 127)] = f2bf(v); });
    __syncthreads();
    {
      const int i = tid >> 3, isk_ = (tid >> 2) & 1, qr = tid & 3;
      const bf16_t* src = (isk_ ? RK : RQ) + i * 136 + qr * 32;
      float ss = 0.f;
#pragma unroll
      for (int c = 0; c < 4; ++c) {
        const u32x4 x = *(const u32x4*)(src + c * 8);
        ss += bflo(x.x) * bflo(x.x) + bfhi(x.x) * bfhi(x.x) + bflo(x.y) * bflo(x.y) + bfhi(x.y) * bfhi(x.y)
            + bflo(x.z) * bflo(x.z) + bfhi(x.z) * bfhi(x.z) + bflo(x.w) * bflo(x.w) + bfhi(x.w) * bfhi(x.w);
      }
      ss += dppf<0xB1>(ss); ss += dppf<0x4E>(ss);
      if (qr == 0) {
        const float rr = rsqrtf(ss + 1e-6f);
        if (isk_) { sc[128 + i] = rr; sc[192 + i] = sc[64 + i] * sc[32 + i] * rr; }
        else sc[96 + i] = rr * 0.08838834764831845f;
      }
    }
    __syncthreads();
    if (ci + 1 < nch) { DN_PREFETCH(ci + 1); DN_PREFSC(ci + 1); }
    f32x4 QK = (f32x4){0.f, 0.f, 0.f, 0.f};
    {
      f32x4 KK = (f32x4){0.f, 0.f, 0.f, 0.f};
#pragma unroll
      for (int kk = 0; kk < 4; ++kk) {
        const bf16x8 qa0 = *(const bf16x8*)(RQ + (16 * rt + fr) * 136 + kk * 32 + fq * 8);
        const bf16x8 ka = *(const bf16x8*)(RK + (16 * rt + fr) * 136 + kk * 32 + fq * 8);
        const bf16x8 kb = *(const bf16x8*)(RK + (16 * ch + fr) * 136 + kk * 32 + fq * 8);
        KK = __builtin_amdgcn_mfma_f32_16x16x32_bf16(ka, kb, KK, 0, 0, 0);
        QK = __builtin_amdgcn_mfma_f32_16x16x32_bf16(qa0, kb, QK, 0, 0, 0);
      }
      float* Am = (float*)RAb;
      const int j = 16 * ch + fr;
      const float gj = sc[j], rkj = sc[128 + j];
#pragma unroll
      for (int jj = 0; jj < 4; ++jj) {
        const int i = 16 * rt + fq * 4 + jj;
        const float dec = __expf(sc[i] - gj);
        Am[j * 36 + i] = (j < i) ? sc[64 + i] * sc[128 + i] * rkj * dec * KK[jj] : 0.f;
        QK[jj] = (j <= i) ? sc[96 + i] * rkj * dec * QK[jj] : 0.f;
      }
    }
    __syncthreads();
#pragma unroll
    for (int u = 0; u < 2; ++u) {
      const int idx = tid + 256 * u;
      const int j = idx & 31, kd8 = idx >> 5;
      const u32x4 kx = *(const u32x4*)(RK + j * 136 + kd8 * 8);
      const float s = sc[128 + j] * sc[160 + j];
      RE[(kd8 * 8 + 0) * 40 + j] = f2bf(bflo(kx.x) * s); RE[(kd8 * 8 + 1) * 40 + j] = f2bf(bfhi(kx.x) * s);
      RE[(kd8 * 8 + 2) * 40 + j] = f2bf(bflo(kx.y) * s); RE[(kd8 * 8 + 3) * 40 + j] = f2bf(bfhi(kx.y) * s);
      RE[(kd8 * 8 + 4) * 40 + j] = f2bf(bflo(kx.z) * s); RE[(kd8 * 8 + 5) * 40 + j] = f2bf(bfhi(kx.z) * s);
      RE[(kd8 * 8 + 6) * 40 + j] = f2bf(bflo(kx.w) * s); RE[(kd8 * 8 + 7) * 40 + j] = f2bf(bfhi(kx.w) * s);
    }
    if (tid < 192) {
      const float* Am = (const float*)RAb;
      const float* rs = isk ? (sc + 192) : (sc + 64);
#pragma unroll
      for (int i = 0; i < 16; ++i) kvp[i] *= (f32v2){rs[2 * i], rs[2 * i + 1]};
#pragma unroll
      for (int j = 0; j < 31; ++j) {
        const float xj = KV(j);
        int off = j * 36;
        asm volatile("" : "+v"(off) : "v"(xj));
        const f32v2 xx = (f32v2){xj, xj};
#pragma unroll
        for (int q = (j + 1) >> 2; q < 8; ++q) {
          const float4 a = *(const float4*)(Am + off + q * 4);
          kvp[2 * q] -= (f32v2){a.x, a.y} * xx;
          kvp[2 * q + 1] -= (f32v2){a.z, a.w} * xx;
        }
      }
    }
    if (isk) {
#pragma unroll
      for (int i = 0; i < 32; ++i) RW[i * 136 + tid] = f2bf(KV(i));
    } else if (isv) {
#pragma unroll
      for (int i = 0; i < 32; ++i) RU[i * 65 + (tid - 128)] = KV(i);
    }
    __syncthreads();
    f32x4 O[2], VN[2];
    O[0] = (f32x4){0.f, 0.f, 0.f, 0.f}; O[1] = O[0]; VN[0] = O[0]; VN[1] = O[0];
#pragma unroll
    for (int kk = 0; kk < 4; ++kk) {
      const bf16x8 wa = *(const bf16x8*)(RW + (16 * rt + fr) * 136 + kk * 32 + fq * 8);
      const bf16x8 qa1 = *(const bf16x8*)(RQ + (16 * rt + fr) * 136 + kk * 32 + fq * 8);
#pragma unroll
      for (int t = 0; t < 2; ++t) {
        const bf16x8 sb = *(const bf16x8*)(RS + ((2 * ch + t) * 16 + fr) * 136 + kk * 32 + fq * 8);
        VN[t] = __builtin_amdgcn_mfma_f32_16x16x32_bf16(wa, sb, VN[t], 0, 0, 0);
        O[t] = __builtin_amdgcn_mfma_f32_16x16x32_bf16(qa1, sb, O[t], 0, 0, 0);
      }
    }
    {
      bf16_t* QKd = (bf16_t*)RAb;
#pragma unroll
      for (int jj = 0; jj < 4; ++jj) {
        const int i = 16 * rt + fq * 4 + jj;
        const float osc = sc[96 + i] * sc[32 + i];
#pragma unroll
        for (int t = 0; t < 2; ++t) {
          const int v = (2 * ch + t) * 16 + fr;
          const float vn = RU[i * 65 + v] - VN[t][jj];
          O[t][jj] *= osc;
          RV[v * 40 + i] = f2bf(vn);
        }
        QKd[i * 40 + 16 * ch + fr] = f2bf(QK[jj]);
      }
    }
    __syncthreads();
    {
      const bf16_t* QKd = (const bf16_t*)RAb;
      const float el = sc[224];
      const bf16x8 pa = *(const bf16x8*)(QKd + (16 * rt + fr) * 40 + fq * 8);
      bf16x8 vb[4];
#pragma unroll
      for (int n = 0; n < 4; ++n) vb[n] = *(const bf16x8*)(RV + (n * 16 + fr) * 40 + fq * 8);
#pragma unroll
      for (int t = 0; t < 2; ++t) O[t] = __builtin_amdgcn_mfma_f32_16x16x32_bf16(pa, (ch == 0 ? vb[t] : vb[2 + t]), O[t], 0, 0, 0);
#pragma unroll
      for (int m = 0; m < 2; ++m) {
        const bf16x8 ke = *(const bf16x8*)(RE + (32 * w + m * 16 + fr) * 40 + fq * 8);
#pragma unroll
        for (int n = 0; n < 4; ++n) {
          accS[m][n] *= el;
          accS[m][n] = __builtin_amdgcn_mfma_f32_16x16x32_bf16(ke, vb[n], accS[m][n], 0, 0, 0);
        }
      }
#pragma unroll
      for (int jj = 0; jj < 4; ++jj) {
        const int i = 16 * rt + fq * 4 + jj;
        const int t = tpos0 + step * i;
#pragma unroll
        for (int u = 0; u < 2; ++u) Pout[(size_t)(row0 + t) * 2048 + 1024 + h * 128 + half * 64 + (2 * ch + u) * 16 + fr] = f2bf(O[u][jj]);
      }
    }
  }
  __builtin_amdgcn_s_setprio(0);
#undef KV
#undef DN_PREFETCH
#undef DN_PREFSC
  if (seq < 32) {
    float* so = p.out + OUT_DN + ((size_t)((seq * 2 + dir) * 8 + h)) * 16384 + half * 64;
#pragma unroll
    for (int m = 0; m < 2; ++m)
#pragma unroll
      for (int n = 0; n < 4; ++n)
#pragma unroll
        for (int jj = 0; jj < 4; ++jj) so[(32 * w + m * 16 + fq * 4 + jj) * 128 + n * 16 + fr] = accS[m][n][jj];
  }
}

__device__ __forceinline__ void scan_phase(const Params& p, unsigned char* smem) {
  const int nb = gridDim.x, b = blockIdx.x;
  constexpr int NITEM = 2176;
  int first, step;
  if (b < 128) { first = b; step = NITEM; } else { first = b; step = nb - 128; }
  for (int rep_ = 0; rep_ < ((b < 128 && PROBE_LONG2) ? 2 : 1); ++rep_)
  for (int item = first; item < NITEM; item += step) {
    const bool isdn = item < 64 || (item >= 128 && item < 1152);
    if (!isdn) continue;
    const int i = item < 64 ? ((item & 7) * 8 + (item >> 3)) : item - 128;
    const int r_ = i >> 3;
    const bool lg_ = item < 64;
    dn_item(p, lg_ ? 32 + i / 32 : (r_ >> 2), lg_ ? ((i >> 4) & 1) : ((r_ >> 1) & 1), lg_ ? ((i >> 1) & 7) : (i & 7), lg_ ? (i & 1) : (r_ & 1), smem);
  }
  for (int rep_ = 0; rep_ < ((b < 128 && PROBE_LONG2) ? 2 : 1); ++rep_)
  for (int item = first; item < NITEM; item += step) {
    const bool isdn = item < 64 || (item >= 128 && item < 1152);
    if (isdn) continue;
    const int i = item < 128 ? (((item - 64) & 7) * 8 + ((item - 64) >> 3)) : item - 1152;
    const int seq = item < 128 ? 32 + i / 32 : i / 32;
    ssd_item(p, seq, (i >> 4) & 1, i & 15, smem);
  }
}

__device__ __forceinline__ void combine0_phase(const Params& p) {
  const int lane = threadIdx.x & 63, w = threadIdx.x >> 6;
  bf16_t* Pf = (bf16_t*)(p.ws + OFF_PF);
  const bf16_t* Pb = (const bf16_t*)p.out;
  const bf16_t* proj = (const bf16_t*)(p.ws + OFF_B);
  for (int row = blockIdx.x * 4 + w; row < TTOK; row += gridDim.x * 4) {
    const int c = lane * 16;
    {
      u32x4 f[2], bq[2], z[2];
      f[0] = *(const u32x4*)(Pf + (size_t)row * 2048 + c); f[1] = *(const u32x4*)(Pf + (size_t)row * 2048 + c + 8);
      bq[0] = *(const u32x4*)(Pb + (size_t)row * 2048 + c); bq[1] = *(const u32x4*)(Pb + (size_t)row * 2048 + c + 8);
      z[0] = *(const u32x4*)(proj + (size_t)row * 7232 + c); z[1] = *(const u32x4*)(proj + (size_t)row * 7232 + c + 8);
      const unsigned* fu = (const unsigned*)f; const unsigned* bu = (const unsigned*)bq; const unsigned* zu = (const unsigned*)z;
      float y[16]; float ss = 0.f;
#pragma unroll
      for (int e = 0; e < 8; ++e) {
        y[2 * e] = (bflo(fu[e]) + bflo(bu[e])) * siluf(bflo(zu[e]));
        y[2 * e + 1] = (bfhi(fu[e]) + bfhi(bu[e])) * siluf(bfhi(zu[e]));
        ss += y[2 * e] * y[2 * e] + y[2 * e + 1] * y[2 * e + 1];
      }
      ss = wsum(ss);
      const float rstd = rsqrtf(ss * (1.f / 1024.f) + 1e-6f);
      const float* nw = p.in[35] + c;
      u32x4 o[2]; unsigned* ou = (unsigned*)o;
#pragma unroll
      for (int e = 0; e < 8; ++e) ou[e] = pack2(y[2 * e] * rstd * nw[2 * e], y[2 * e + 1] * rstd * nw[2 * e + 1]);
      *(u32x4*)(Pf + (size_t)row * 2048 + c) = o[0]; *(u32x4*)(Pf + (size_t)row * 2048 + c + 8) = o[1];
    }
    {
      u32x4 f[2], bq[2], g[2];
      f[0] = *(const u32x4*)(Pf + (size_t)row * 2048 + 1024 + c); f[1] = *(const u32x4*)(Pf + (size_t)row * 2048 + 1024 + c + 8);
      bq[0] = *(const u32x4*)(Pb + (size_t)row * 2048 + 1024 + c); bq[1] = *(const u32x4*)(Pb + (size_t)row * 2048 + 1024 + c + 8);
      g[0] = *(const u32x4*)(proj + (size_t)row * 7232 + 6176 + c); g[1] = *(const u32x4*)(proj + (size_t)row * 7232 + 6176 + c + 8);
      const unsigned* fu = (const unsigned*)f; const unsigned* bu = (const unsigned*)bq; const unsigned* gu = (const unsigned*)g;
      float y[16]; float ss = 0.f;
#pragma unroll
      for (int e = 0; e < 8; ++e) {
        y[2 * e] = bflo(fu[e]) + bflo(bu[e]);
        y[2 * e + 1] = bfhi(fu[e]) + bfhi(bu[e]);
        ss += y[2 * e] * y[2 * e] + y[2 * e + 1] * y[2 * e + 1];
      }
      ss += dppf<0xB1>(ss); ss += dppf<0x4E>(ss); ss += dppf<0x141>(ss);
      const float rstd = rsqrtf(ss * (1.f / 128.f) + 1e-6f);
      const float* nw = p.in[39] + (c & 127);
      u32x4 o[2]; unsigned* ou = (unsigned*)o;
#pragma unroll
      for (int e = 0; e < 8; ++e)
        ou[e] = pack2(y[2 * e] * rstd * nw[2 * e] * siluf(bflo(gu[e])), y[2 * e + 1] * rstd * nw[2 * e + 1] * siluf(bfhi(gu[e])));
      *(u32x4*)(Pf + (size_t)row * 2048 + 1024 + c) = o[0]; *(u32x4*)(Pf + (size_t)row * 2048 + 1024 + c + 8) = o[1];
    }
  }
}

__device__ __forceinline__ void convact_phase(const Params& p, int layer) {
  const float* cw = p.in[layer == 0 ? 15 : 25];
  const float* cb = p.in[layer == 0 ? 16 : 26];
  const bf16_t* up = (const bf16_t*)(p.ws + OFF_C);
  bf16_t* act = (bf16_t*)(p.ws + OFF_ACT);
  const int total = (TTOK / 8) * 352;
  for (int u = blockIdx.x * NT + threadIdx.x; u < total; u += gridDim.x * NT) {
    const int rb = u / 352, j = (u % 352) * 8;
    float wa[3][8], wb[3][8], ba[8], bb[8];
#pragma unroll
    for (int t = 0; t < 3; ++t) {
#pragma unroll
      for (int e = 0; e < 8; e += 4) {
        const float4 x = *(const float4*)(cw + t * 5632 + j + e);
        wa[t][e] = x.x; wa[t][e + 1] = x.y; wa[t][e + 2] = x.z; wa[t][e + 3] = x.w;
        const float4 y = *(const float4*)(cw + t * 5632 + 2816 + j + e);
        wb[t][e] = y.x; wb[t][e + 1] = y.y; wb[t][e + 2] = y.z; wb[t][e + 3] = y.w;
      }
    }
#pragma unroll
    for (int e = 0; e < 8; e += 4) {
      const float4 x = *(const float4*)(cb + j + e);
      ba[e] = x.x; ba[e + 1] = x.y; ba[e + 2] = x.z; ba[e + 3] = x.w;
      const float4 y = *(const float4*)(cb + 2816 + j + e);
      bb[e] = y.x; bb[e + 1] = y.y; bb[e + 2] = y.z; bb[e + 3] = y.w;
    }
    const int T0 = rb * 8;
    int t0, L;
    if (T0 < TP) { t0 = T0 & 255; L = 256; } else { t0 = (T0 - TP) & 2047; L = 2048; }
    float pa[8], pb[8], ca[8], cbv[8], na[8], nbv[8];
    const u32x4 zero4 = (u32x4){0u, 0u, 0u, 0u};
    {
      u32x4 xa = zero4, xb = zero4;
      if (t0 > 0) { xa = *(const u32x4*)(up + (size_t)(T0 - 1) * 5632 + j); xb = *(const u32x4*)(up + (size_t)(T0 - 1) * 5632 + 2816 + j); }
      const unsigned* ua = (const unsigned*)&xa; const unsigned* ub = (const unsigned*)&xb;
#pragma unroll
      for (int e = 0; e < 4; ++e) { pa[2 * e] = bflo(ua[e]); pa[2 * e + 1] = bfhi(ua[e]); pb[2 * e] = bflo(ub[e]); pb[2 * e + 1] = bfhi(ub[e]); }
      xa = *(const u32x4*)(up + (size_t)T0 * 5632 + j); xb = *(const u32x4*)(up + (size_t)T0 * 5632 + 2816 + j);
#pragma unroll
      for (int e = 0; e < 4; ++e) { ca[2 * e] = bflo(ua[e]); ca[2 * e + 1] = bfhi(ua[e]); cbv[2 * e] = bflo(ub[e]); cbv[2 * e + 1] = bfhi(ub[e]); }
    }
#pragma unroll
    for (int r = 0; r < 8; ++r) {
      u32x4 xa = zero4, xb = zero4;
      if (t0 + r + 1 < L) { xa = *(const u32x4*)(up + (size_t)(T0 + r + 1) * 5632 + j); xb = *(const u32x4*)(up + (size_t)(T0 + r + 1) * 5632 + 2816 + j); }
      const unsigned* ua = (const unsigned*)&xa; const unsigned* ub = (const unsigned*)&xb;
#pragma unroll
      for (int e = 0; e < 4; ++e) { na[2 * e] = bflo(ua[e]); na[2 * e + 1] = bfhi(ua[e]); nbv[2 * e] = bflo(ub[e]); nbv[2 * e + 1] = bfhi(ub[e]); }
      float o[8];
#pragma unroll
      for (int e = 0; e < 8; ++e) {
        const float a = pa[e] * wa[0][e] + ca[e] * wa[1][e] + na[e] * wa[2][e] + ba[e];
        const float b = pb[e] * wb[0][e] + cbv[e] * wb[1][e] + nbv[e] * wb[2][e] + bb[e];
        o[e] = siluf(a) * b;
        pa[e] = ca[e]; ca[e] = na[e]; pb[e] = cbv[e]; cbv[e] = nbv[e];
      }
      u32x4 ov; ov.x = pack2(o[0], o[1]); ov.y = pack2(o[2], o[3]); ov.z = pack2(o[4], o[5]); ov.w = pack2(o[6], o[7]);
      *(u32x4*)(act + (size_t)(T0 + r) * 2816 + j) = ov;
    }
  }
}

__device__ __forceinline__ void lnstat_rows(const Params& p) {
  const int lane = threadIdx.x & 63, w = threadIdx.x >> 6;
  const bf16_t* proj = (const bf16_t*)(p.ws + OFF_C);
  float* stat = (float*)(p.ws + OFF_SMALL);
  for (int row = blockIdx.x * 4 + w; row < TTOK; row += gridDim.x * 4) {
    const bf16_t* src = proj + (size_t)row * 3584 + 1024 + lane * 16;
    const u32x4 x0 = *(const u32x4*)src, x1 = *(const u32x4*)(src + 8);
    float v[16];
    v[0] = bflo(x0.x); v[1] = bfhi(x0.x); v[2] = bflo(x0.y); v[3] = bfhi(x0.y); v[4] = bflo(x0.z); v[5] = bfhi(x0.z); v[6] = bflo(x0.w); v[7] = bfhi(x0.w);
    v[8] = bflo(x1.x); v[9] = bfhi(x1.x); v[10] = bflo(x1.y); v[11] = bfhi(x1.y); v[12] = bflo(x1.z); v[13] = bfhi(x1.z); v[14] = bflo(x1.w); v[15] = bfhi(x1.w);
    float sm = 0.f;
#pragma unroll
    for (int e = 0; e < 16; ++e) sm += v[e];
    const float mean = wsum(sm) * (1.f / 1024.f);
    float q = 0.f;
#pragma unroll
    for (int e = 0; e < 16; ++e) { const float d = v[e] - mean; q += d * d; }
    const float var = wsum(q) * (1.f / 1024.f);
    if (lane == 0) { stat[row * 2] = mean; stat[row * 2 + 1] = rsqrtf(var + 1e-6f); }
  }
}

__device__ __forceinline__ void gate_item(const Params& p, int item, unsigned char* smem) {
  bf16_t* Gt = (bf16_t*)smem;
  const int tid = threadIdx.x, lane = tid & 63, w = tid >> 6, fr = lane & 15, fq = lane >> 4;
  const int ch = item >> 3, g = (item >> 1) & 3, dh = item & 1;
  const int T0 = ch * 128;
  const bf16_t* proj = (const bf16_t*)(p.ws + OFF_C);
  bf16_t* mixed = (bf16_t*)(p.ws + OFF_PF);
  const bf16_t* Wsb = (const bf16_t*)(p.ws + OFF_WSB);
  const float* stat = (const float*)(p.ws + OFF_SMALL);
  const int cb0 = g * 256 + dh * 128;
  __syncthreads();
#pragma unroll
  for (int i = 0; i < 8; ++i) {
    const int idx = tid + 256 * i;
    const int j = idx >> 4, d8 = idx & 15;
    const int cbase = cb0 + d8 * 8;
    const u32x4 x = *(const u32x4*)(proj + (size_t)(T0 + j) * 3584 + 1024 + cbase);
    const unsigned* xu = (const unsigned*)&x;
    const float mean = stat[(T0 + j) * 2], rstd = stat[(T0 + j) * 2 + 1];
    const float* lw = p.in[42] + cbase; const float* lb = p.in[43] + cbase;
    const int jc = (((j >> 3) ^ d8) << 3) + (j & 7);
#pragma unroll
    for (int e = 0; e < 4; ++e) {
      const float a = (bflo(xu[e]) - mean) * rstd * lw[2 * e] + lb[2 * e];
      const float b = (bfhi(xu[e]) - mean) * rstd * lw[2 * e + 1] + lb[2 * e + 1];
      Gt[(d8 * 8 + 2 * e) * 136 + jc] = f2bf(a);
      Gt[(d8 * 8 + 2 * e + 1) * 136 + jc] = f2bf(b);
    }
  }
  __syncthreads();
  f32x4 acc[2][8];
#pragma unroll
  for (int m = 0; m < 2; ++m)
#pragma unroll
    for (int n = 0; n < 8; ++n) acc[m][n] = (f32x4){0.f, 0.f, 0.f, 0.f};
#pragma unroll
  for (int kk = 0; kk < 4; ++kk) {
    bf16x8 a[2];
#pragma unroll
    for (int m = 0; m < 2; ++m) a[m] = *(const bf16x8*)(Wsb + g * 16384 + (w * 32 + m * 16 + fr) * 128 + kk * 32 + fq * 8);
#pragma unroll
    for (int n = 0; n < 8; ++n) {
      const int d = n * 16 + fr;
      const bf16x8 b = *(const bf16x8*)(Gt + d * 136 + (((kk * 4 + fq) ^ (d >> 3)) << 3));
#pragma unroll
      for (int m = 0; m < 2; ++m) acc[m][n] = __builtin_amdgcn_mfma_f32_16x16x32_bf16(b, a[m], acc[m][n], 0, 0, 0);
    }
  }
  __syncthreads();
  float* Ow = (float*)smem + w * 4224;
#pragma unroll
  for (int m = 0; m < 2; ++m) {
    const float bias = p.in[45][g * 128 + w * 32 + m * 16 + fr];
#pragma unroll
    for (int n = 0; n < 8; ++n)
      *(float4*)(Ow + (m * 16 + fr) * 132 + n * 16 + fq * 4) = make_float4(acc[m][n][0] + bias, acc[m][n][1] + bias, acc[m][n][2] + bias, acc[m][n][3] + bias);
  }
  asm volatile("s_waitcnt lgkmcnt(0)" ::: "memory");
#pragma unroll
  for (int i = 0; i < 8; ++i) {
    const int r = i * 4 + (lane >> 4), c8 = (lane & 15) * 8;
    const float4 s0 = *(const float4*)(Ow + r * 132 + c8), s1 = *(const float4*)(Ow + r * 132 + c8 + 4);
    const size_t T = (size_t)(T0 + w * 32 + r);
    const u32x4 u = *(const u32x4*)(proj + T * 3584 + cb0 + c8);
    u32x4 o;
    o.x = pack2(bflo(u.x) * s0.x, bfhi(u.x) * s0.y); o.y = pack2(bflo(u.y) * s0.z, bfhi(u.y) * s0.w);
    o.z = pack2(bflo(u.z) * s1.x, bfhi(u.z) * s1.y); o.w = pack2(bflo(u.w) * s1.z, bfhi(u.w) * s1.w);
    *(u32x4*)(mixed + T * 2048 + cb0 + c8) = o;
  }
}

__device__ __forceinline__ void attn_item(const Params& p, int item, unsigned char* smem) {
  bf16_t* Ks = (bf16_t*)smem;
  bf16_t* Vs = Ks + 64 * 136;
  bf16_t* Ps = Vs + 128 * 72;
  const int tid = threadIdx.x, lane = tid & 63, w = tid >> 6, fr = lane & 15, fq = lane >> 4;
  int seq, hq, qt;
  if (item < 1024) { seq = item >> 5; hq = (item >> 2) & 7; qt = item & 3; }
  else { const int i = item - 1024; seq = 32 + (i >> 8); hq = (i >> 5) & 7; qt = i & 31; }
  const bool sample = seq >= 32;
  const int sb = seq - 32;
  const int row0 = sample ? TP + sb * 2048 : seq * 256;
  const int kvh = hq >> 2;
  const int q0 = qt * 64;
  const bf16_t* proj = (const bf16_t*)(p.ws + OFF_C);
  const bf16_t* vT = (const bf16_t*)(p.ws + OFF_VT);
  const bf16_t* Kc = (const bf16_t*)(p.ws + OFF_KC);
  const bf16_t* VcT = (const bf16_t*)(p.ws + OFF_VCT);
  const float* cosT = (const float*)(p.ws + OFF_COS);
  const float* sinT = (const float*)(p.ws + OFF_SIN);
  bf16_t* mixed = (bf16_t*)(p.ws + OFF_PF);

  bf16x8 qa[4];
  {
    const int qrow = q0 + w * 16 + fr;
    const bf16_t* qp = proj + (size_t)(row0 + qrow) * 3584 + 2048 + hq * 128;
#pragma unroll
    for (int kk = 0; kk < 4; ++kk) qa[kk] = *(const bf16x8*)(qp + kk * 32 + fq * 8);
    if (sample) {
#pragma unroll
      for (int kk = 0; kk < 2; ++kk)
#pragma unroll
        for (int e = 0; e < 8; ++e) {
          const int i = kk * 32 + fq * 8 + e;
          const float c = cosT[qrow * 64 + i], s = sinT[qrow * 64 + i];
          const float x1 = bf2f((unsigned short)qa[kk][e]), x2 = bf2f((unsigned short)qa[kk + 2][e]);
          qa[kk][e] = (short)f2bf(x1 * c - x2 * s);
          qa[kk + 2][e] = (short)f2bf(x2 * c + x1 * s);
        }
    }
  }
  float m_[4], l_[4];
  f32x4 o[8];
#pragma unroll
  for (int j = 0; j < 4; ++j) { m_[j] = -1e30f; l_[j] = 0.f; }
#pragma unroll
  for (int n = 0; n < 8; ++n) o[n] = (f32x4){0.f, 0.f, 0.f, 0.f};
  int nl, ks0, nct;
  if (!sample) { nl = 4; ks0 = 0; nct = 0; }
  else {
    const int lo = q0 - 128 < 0 ? 0 : q0 - 128;
    const int hi = q0 + 192 > 2048 ? 2048 : q0 + 192;
    ks0 = lo; nl = (hi - lo) >> 6; nct = 8;
  }
  const int ntot = nl + nct;
  u32x4 kreg[4], vreg[4];
#define ATT_LOAD(k_) { const int kt_ = (k_) < nl ? 0 : 1; const int ks_ = kt_ == 0 ? ks0 + (k_) * 64 : ((k_) - nl) * 64; \
    _Pragma("unroll") for (int i = 0; i < 2; ++i) { const int idx = tid + 256 * i; const int r = idx >> 3, c8 = idx & 7; \
      const bf16_t* src = kt_ == 0 ? proj + (size_t)(row0 + ks_ + r) * 3584 + 3072 + kvh * 128 : Kc + ((size_t)((sb * 2 + kvh) * 512 + ks_ + r)) * 128; \
      kreg[2 * i] = *(const u32x4*)(src + c8 * 8); kreg[2 * i + 1] = *(const u32x4*)(src + 64 + c8 * 8); } \
    _Pragma("unroll") for (int i = 0; i < 4; ++i) { const int idx = tid + 256 * i; const int d = idx >> 3, c8 = idx & 7; \
      const bf16_t* src = kt_ == 0 ? vT + (size_t)(kvh * 128 + d) * TTOK + row0 + ks_ : VcT + ((size_t)((sb * 2 + kvh) * 128 + d)) * 512 + ks_; \
      vreg[i] = *(const u32x4*)(src + c8 * 8); } }
  ATT_LOAD(0);
  for (int k = 0; k < ntot; ++k) {
    const int ktype = k < nl ? 0 : 1;
    const int ks = ktype == 0 ? ks0 + k * 64 : (k - nl) * 64;
    __syncthreads();
#pragma unroll
    for (int i = 0; i < 2; ++i) {
      const int idx = tid + 256 * i;
      const int r = idx >> 3, c8 = idx & 7;
      u32x4 lo = kreg[2 * i], hi = kreg[2 * i + 1];
      if (sample && ktype == 0) {
        unsigned* lu = (unsigned*)&lo; unsigned* hu = (unsigned*)&hi;
        const float* cp = cosT + (ks + r) * 64 + c8 * 8; const float* sp = sinT + (ks + r) * 64 + c8 * 8;
#pragma unroll
        for (int e = 0; e < 4; ++e) {
          const float a1 = bflo(lu[e]), b1 = bfhi(lu[e]), a2 = bflo(hu[e]), b2 = bfhi(hu[e]);
          const float c0 = cp[2 * e], s0 = sp[2 * e], c1 = cp[2 * e + 1], s1 = sp[2 * e + 1];
          lu[e] = pack2(a1 * c0 - a2 * s0, b1 * c1 - b2 * s1);
          hu[e] = pack2(a2 * c0 + a1 * s0, b2 * c1 + b1 * s1);
        }
      }
      *(u32x4*)(Ks + r * 136 + c8 * 8) = lo;
      *(u32x4*)(Ks + r * 136 + 64 + c8 * 8) = hi;
    }
#pragma unroll
    for (int i = 0; i < 4; ++i) {
      const int idx = tid + 256 * i;
      const int d = idx >> 3, c8 = idx & 7;
      *(u32x4*)(Vs + d * 72 + c8 * 8) = vreg[i];
    }
    __syncthreads();
    if (k + 1 < ntot) ATT_LOAD(k + 1);
    f32x4 s[4];
#pragma unroll
    for (int n = 0; n < 4; ++n) s[n] = (f32x4){0.f, 0.f, 0.f, 0.f};
#pragma unroll
    for (int kk = 0; kk < 4; ++kk)
#pragma unroll
      for (int n = 0; n < 4; ++n) {
        const bf16x8 b = *(const bf16x8*)(Ks + (n * 16 + fr) * 136 + kk * 32 + fq * 8);
        s[n] = __builtin_amdgcn_mfma_f32_16x16x32_bf16(qa[kk], b, s[n], 0, 0, 0);
      }
    const bool domask = sample && ktype == 0;
#pragma unroll
    for (int j = 0; j < 4; ++j) {
      float mx = -1e30f;
#pragma unroll
      for (int n = 0; n < 4; ++n) {
        float v = s[n][j] * 0.08838834764831845f;
        if (domask) {
          const int dd = (q0 + w * 16 + fq * 4 + j) - (ks + n * 16 + fr);
          if (dd > 128 || dd < -128) v = -1e30f;
        }
        s[n][j] = v;
        mx = fmaxf(mx, v);
      }
      mx = row16_max(mx);
      const float mnew = fmaxf(m_[j], mx);
      const float alpha = __expf(m_[j] - mnew);
      m_[j] = mnew;
      l_[j] *= alpha;
#pragma unroll
      for (int nd = 0; nd < 8; ++nd) o[nd][j] *= alpha;
#pragma unroll
      for (int n = 0; n < 4; ++n) {
        const float pv = __expf(s[n][j] - mnew);
        l_[j] += pv;
        Ps[w * 1152 + (fq * 4 + j) * 72 + n * 16 + fr] = f2bf(pv);
      }
    }
    __syncthreads();
#pragma unroll
    for (int kk2 = 0; kk2 < 2; ++kk2) {
      const bf16x8 pa = *(const bf16x8*)(Ps + w * 1152 + fr * 72 + kk2 * 32 + fq * 8);
#pragma unroll
      for (int nd = 0; nd < 8; ++nd) {
        const bf16x8 vb = *(const bf16x8*)(Vs + (nd * 16 + fr) * 72 + kk2 * 32 + fq * 8);
        o[nd] = __builtin_amdgcn_mfma_f32_16x16x32_bf16(pa, vb, o[nd], 0, 0, 0);
      }
    }
  }
#undef ATT_LOAD
  const float sink = p.in[46][hq];
#pragma unroll
  for (int j = 0; j < 4; ++j) {
    float lt = l_[j];
    lt = row16_sum(lt);
    const float mf = fmaxf(m_[j], sink);
    const float sc = __expf(m_[j] - mf);
    const float den = lt * sc + __expf(sink - mf);
    const float inv = sc / den;
    const int T = row0 + q0 + w * 16 + fq * 4 + j;
#pragma unroll
    for (int nd = 0; nd < 8; ++nd) mixed[(size_t)T * 2048 + 1024 + hq * 128 + nd * 16 + fr] = f2bf(o[nd][j] * inv);
  }
}

__device__ __forceinline__ void mixer1a_phase(const Params& p, unsigned char* smem) {
  lnstat_rows(p);
  constexpr int NATT = 1536;
  for (int it = blockIdx.x; it < NATT; it += gridDim.x) {
    const int a = it < 512 ? 1024 + it : it - 512;
    for (int r_ = 0; r_ < (PROBE_ATT2 ? 2 : 1); ++r_) attn_item(p, a, smem);
  }
}
__device__ __forceinline__ void mixer1b_phase(const Params& p, unsigned char* smem) {
  constexpr int NGATE = 768;
  for (int it = blockIdx.x; it < NGATE; it += gridDim.x)
    for (int r_ = 0; r_ < (PROBE_GATE2 ? 2 : 1); ++r_) gate_item(p, it, smem);
}

__device__ __forceinline__ void wconv_late(const Params& p, unsigned char* smem) {
  constexpr int C0 = 16 * 88, C1 = 44 * 16, C2 = 16 * 56, C3 = 32 * 16, C4 = 16 * 88, C5 = 44 * 16;
  constexpr int TOT = C0 + C1 + C2 + C3 + C4 + C5;
  for (int it = blockIdx.x; it < TOT; it += gridDim.x) {
    int i = it;
    const float* src; int K, N; size_t off;
    if (i < C0) { src = p.in[14]; K = 1024; N = 5632; off = OFF_WUP0; }
    else if ((i -= C0) < C1) { src = p.in[17]; K = 2816; N = 1024; off = OFF_WDN0; }
    else if ((i -= C1) < C2) { src = p.in[40]; K = 1024; N = 3584; off = OFF_WIN1; }
    else if ((i -= C2) < C3) { src = p.in[41]; K = 2048; N = 1024; off = OFF_WOUT1; }
    else if ((i -= C3) < C4) { src = p.in[24]; K = 1024; N = 5632; off = OFF_WUP1; }
    else { i -= C4; src = p.in[27]; K = 2816; N = 1024; off = OFF_WDN1; }
    tconv_item(src, K, N, (bf16_t*)(p.ws + off), i, smem);
  }
}

__global__ __launch_bounds__(NT, 2) void mk_kernel(Params p) {
  extern __shared__ __attribute__((aligned(16))) unsigned char smem[];
  cg::grid_group grid = cg::this_grid();
  unsigned char* ws = p.ws;
#ifndef REPMASK
#define REPMASK 0
#endif
#define PH_REP(k) (((REPMASK >> (k)) & 1) ? 2 : 1)
  __shared__ uint4 xb_words;
  if (threadIdx.x == 0) xb_words = make_uint4(0u, 0u, 0u, 0u);
  __syncthreads();
  XcdBarrier xb = xcd_barrier_post((unsigned*)(p.ws + WS_NEED), (volatile LAS unsigned*)&xb_words);
  if (p.ph_lo < 0) grid.sync();
#define GSYNC() xcd_barrier(xb)
#define PHASE(k, ...) if (PH_ON(k) && p.ph_lo <= (k) && (k) < p.ph_hi) { for (int r_ = 0; r_ < PH_REP(k); ++r_) { if ((k) > p.ph_lo || r_ > 0) GSYNC(); __VA_ARGS__ } }
  PHASE(0, prep_phase(p, smem);)
  PHASE(1, norm0_phase(p);)
  PHASE(2, gemm_phase<8>((const bf16_t*)(ws + OFF_PF), 1024, (const bf16_t*)(ws + OFF_WIN0), 1024, 16, 57, 1024, smem,
                         EpiIn0{(bf16_t*)(ws + OFF_B), (float*)(ws + OFF_SMALL)}, 32, 0);)
  PHASE(3, if (blockIdx.x >= 128) {
             gemm_phase<8>((const bf16_t*)(ws + OFF_PF), 1024, (const bf16_t*)(ws + OFF_WIN0), 1024, 32, 57, 1024, smem,
                           EpiIn0{(bf16_t*)(ws + OFF_B), (float*)(ws + OFF_SMALL)}, 0, 128);
             sub_barrier((unsigned*)(p.ws + WS_NEED) + XCD_BAR_WORDS, gridDim.x - 128, (unsigned*)(p.ws + WS_NEED) + XB_TMO);
           }
           scan_phase(p, smem);)
  PHASE(4, combine0_phase(p);)
  PHASE(5, gemm_phase<6>((const bf16_t*)(ws + OFF_PF), 2048, (const bf16_t*)(ws + OFF_WOUT0), 2048, 64, 8, 2048, smem,
                         EpiOp{(bf16_t*)(ws + OFF_C)});
              wconv_late(p, smem);)
  PHASE(6, post_phase(p, 0, 0);)
  PHASE(7, gemm_phase<6>((const bf16_t*)(ws + OFF_PF), 1024, (const bf16_t*)(ws + OFF_WUP0), 1024, 64, 44, 1024, smem,
                         EpiUp{(bf16_t*)(ws + OFF_C)});)
  PHASE(8, convact_phase(p, 0);)
  PHASE(9, gemm_phase<6>((const bf16_t*)(ws + OFF_ACT), 2816, (const bf16_t*)(ws + OFF_WDN0), 2816, 64, 8, 2816, smem,
                         EpiOp{(bf16_t*)(ws + OFF_C)});)
  PHASE(10, post_phase(p, 0, 1);)
  PHASE(11, gemm_phase<8>((const bf16_t*)(ws + OFF_PF), 1024, (const bf16_t*)(ws + OFF_WIN1), 1024, 48, 28, 1024, smem,
                          EpiIn1{(bf16_t*)(ws + OFF_C), (bf16_t*)(ws + OFF_VT), p.out + OUT_K, p.out + OUT_V});)
  PHASE(12, mixer1a_phase(p, smem); GSYNC(); mixer1b_phase(p, smem);)
  PHASE(13, gemm_phase<6>((const bf16_t*)(ws + OFF_PF), 2048, (const bf16_t*)(ws + OFF_WOUT1), 2048, 64, 8, 2048, smem,
                          EpiOp{(bf16_t*)(ws + OFF_C)});)
  PHASE(14, post_phase(p, 1, 0);)
  PHASE(15, gemm_phase<6>((const bf16_t*)(ws + OFF_PF), 1024, (const bf16_t*)(ws + OFF_WUP1), 1024, 64, 44, 1024, smem,
                          EpiUp{(bf16_t*)(ws + OFF_C)});)
  PHASE(16, convact_phase(p, 1);)
  PHASE(17, gemm_phase<6>((const bf16_t*)(ws + OFF_ACT), 2816, (const bf16_t*)(ws + OFF_WDN1), 2816, 64, 8, 2816, smem,
                          EpiOp{(bf16_t*)(ws + OFF_C)});)
  PHASE(18, post_phase(p, 1, 1);)
#ifdef EXTRA_SYNCS
  if (p.ph_hi - p.ph_lo > 1) for (int e_ = 0; e_ < EXTRA_SYNCS; ++e_) GSYNC();
#endif
}

extern "C" void kernel_launch(void* const* d_in, const int* in_sizes, int n_in, void* d_out, int out_size, void* d_ws,
                              size_t ws_size, hipStream_t stream) {
  static int grid = 0;
  if (grid == 0) {
    int dev = 0, cus = 0, per_cu = 0;
    if (n_in != 47 || ws_size < WS_NEED + XCD_BAR_WORDS * 4 + 256) { fprintf(stderr, "kernel_launch: bad n_in %d or ws %zu\n", n_in, ws_size); grid = -1; return; }
    if (hipFuncSetAttribute((const void*)mk_kernel, hipFuncAttributeMaxDynamicSharedMemorySize, LDS_BYTES) != hipSuccess) { grid = -1; return; }
    hipGetDevice(&dev);
    hipDeviceGetAttribute(&cus, hipDeviceAttributeMultiprocessorCount, dev);
    if (hipOccupancyMaxActiveBlocksPerMultiprocessor(&per_cu, (const void*)mk_kernel, NT, LDS_BYTES) != hipSuccess || per_cu < 1) {
      fprintf(stderr, "kernel_launch: occupancy query failed (%d)\n", per_cu); grid = -1; return;
    }
    if (per_cu > 2) per_cu = 2;
    grid = cus * per_cu;
    if (grid < 256 || (grid & 7)) { fprintf(stderr, "kernel_launch: grid %d unsupported\n", grid); grid = -1; return; }
  }
  if (grid < 0) return;
  Params p{};
  for (int i = 0; i < 47; ++i) p.in[i] = (const float*)d_in[i];
  p.out = (float*)d_out;
  p.ws = (unsigned char*)d_ws;
  (void)hipMemsetAsync((char*)d_ws + WS_NEED, 0, XCD_BAR_WORDS * 4 + 256, stream);
#if SINGLE_LAUNCH
  p.ph_lo = 0; p.ph_hi = NPHASE;
  void* args[] = {&p};
  hipError_t e = hipLaunchCooperativeKernel((const void*)mk_kernel, dim3(grid), dim3(NT), args, LDS_BYTES, stream);
  if (e != hipSuccess) fprintf(stderr, "cooperative launch failed: %s (grid %d)\n", hipGetErrorString(e), grid);
#else
  for (int ph = 0; ph < NPHASE; ++ph) {
    p.ph_lo = ph; p.ph_hi = ph + 1;
    hipLaunchKernelGGL(mk_kernel, dim3(grid), dim3(NT), LDS_BYTES, stream, p);
  }
#endif
}
```
